# Optimizing an MI355X kernel written in HIP

```python
import jax, jax.numpy as jnp
from jax import lax
import numpy as np

D_MODEL = 2048
BATCH = 2
SEQ = 16384
DEPTH = 1

D_MIX = D_MODEL
CONV_W = D_MIX // 2
CONV_GROUPS = 16
GLA_HEADS = 4
GLA_DV = D_MIX - CONV_W
HEAD_V = GLA_DV // GLA_HEADS
GLA_DK = GLA_DV // 2
HEAD_K = GLA_DK // GLA_HEADS
GATE_RANK = 16
GATE_TAU = 16
CHUNK = 64
CONV_K = 3
D_FF = 5632
EPS = 1e-6
D_IN = 3 * CONV_W + 2 * GLA_DK + 2 * GLA_DV + GATE_RANK

kernel_name = "hybrid_conv_gla_convffn_adaln"


def rmsnorm(x, w):
    x32 = x.astype(jnp.float32)
    y = x32 * lax.rsqrt(jnp.mean(x32 * x32, axis=-1, keepdims=True) + EPS)
    return (y * w.astype(jnp.float32)).astype(x.dtype)


def causal_dwconv3(u, w):
    s = u.shape[1]
    up = jnp.pad(u, ((0, 0), (CONV_K - 1, 0), (0, 0)))
    return up[:, :s] * w[0] + up[:, 1:s + 1] * w[1] + up[:, 2:] * w[2]


def gla_chunked(q, k, v, log_a):
    bsz, s, h, dk = q.shape
    dv = v.shape[-1]
    nc = s // CHUNK

    def to_chunks(t):
        return t.reshape(bsz, nc, CHUNK, h, t.shape[-1]).transpose(1, 0, 3, 2, 4).astype(jnp.float32)

    mask = jnp.tril(jnp.ones((CHUNK, CHUNK), dtype=bool))[None, None, :, :, None]

    def step(state, inp):
        qc, kc, vc, gc = inp
        b = jnp.cumsum(gc, axis=2)
        diff = b[:, :, :, None, :] - b[:, :, None, :, :]
        decay = jnp.exp(jnp.where(mask, diff, -jnp.inf))
        scores = jnp.einsum('bhid,bhjd,bhijd->bhij', qc, kc, decay)
        o = jnp.einsum('bhij,bhje->bhie', scores, vc) + jnp.einsum('bhid,bhde->bhie', qc * jnp.exp(b), state)
        b_last = b[:, :, -1:, :]
        state = jnp.exp(b_last[:, :, 0, :])[..., None] * state + jnp.einsum(
            'bhjd,bhje->bhde', kc * jnp.exp(b_last - b), vc)
        return state, o

    state0 = jnp.zeros((bsz, h, dk, dv), jnp.float32)
    _, o = lax.scan(step, state0, (to_chunks(q), to_chunks(k), to_chunks(v), to_chunks(log_a)))
    return o.transpose(1, 0, 3, 2, 4).reshape(bsz, s, h, dv)


def hybrid_mixer(h, w_in, conv_w, gate_w2, gate_b, gla_norm_w, w_out):
    bsz, s, _ = h.shape
    proj = h @ w_in
    splits = np.cumsum([CONV_W, CONV_W, CONV_W, GLA_DK, GLA_DK, GLA_DV, GLA_DV])
    cb, cc, cx, q, k, v, r, a_lr = jnp.split(proj, splits, axis=-1)
    y_conv = cb * causal_dwconv3(cc * cx, conv_w)
    log_a = jax.nn.log_sigmoid((a_lr @ gate_w2 + gate_b).astype(jnp.float32)) / GATE_TAU
    q = q.reshape(bsz, s, GLA_HEADS, HEAD_K) * (HEAD_K ** -0.5)
    k = k.reshape(bsz, s, GLA_HEADS, HEAD_K)
    v = v.reshape(bsz, s, GLA_HEADS, HEAD_V)
    log_a = log_a.reshape(bsz, s, GLA_HEADS, HEAD_K)
    o = gla_chunked(q, k, v, log_a).astype(h.dtype)
    o = rmsnorm(o, gla_norm_w) * jax.nn.silu(r.reshape(bsz, s, GLA_HEADS, HEAD_V))
    y_gla = o.reshape(bsz, s, GLA_DV)
    return jnp.concatenate([y_conv, y_gla], axis=-1) @ w_out


def conv_ffn(h, w_up, ffn_conv_w, w_down):
    u = causal_dwconv3(h @ w_up, ffn_conv_w)
    g, val = jnp.split(u, 2, axis=-1)
    return (jax.nn.silu(g) * val) @ w_down


def setup_inputs(seed: int = 0) -> dict:
    key = jax.random.key(seed)
    ks = jax.random.split(key, 20)
    n = jax.random.normal
    f = jnp.float32
    L = DEPTH
    return {
        "x": n(ks[0], (BATCH, SEQ, D_MODEL), f),
        "c": n(ks[1], (BATCH, D_MODEL), f),
        "w_mod": n(ks[2], (L, D_MODEL, 6 * D_MODEL), f) * (0.5 * D_MODEL ** -0.5),
        "b_mod": 0.01 * n(ks[3], (L, 6 * D_MODEL), f),
        "mix_pre_w": 1.0 + 0.05 * n(ks[4], (L, D_MODEL), f),
        "mix_post_w": 1.0 + 0.05 * n(ks[5], (L, D_MODEL), f),
        "w_in": n(ks[6], (L, D_MODEL, D_IN), f) * D_MODEL ** -0.5,
        "conv_w": n(ks[7], (L, CONV_K, CONV_W), f) * CONV_K ** -0.5,
        "gate_w2": n(ks[8], (L, GATE_RANK, GLA_DK), f) * GATE_RANK ** -0.5,
        "gate_b": 0.01 * n(ks[9], (L, GLA_DK), f),
        "gla_norm_w": 1.0 + 0.05 * n(ks[10], (L, HEAD_V), f),
        "w_out": n(ks[11], (L, D_MIX, D_MODEL), f) * D_MIX ** -0.5,
        "ffn_pre_w": 1.0 + 0.05 * n(ks[12], (L, D_MODEL), f),
        "ffn_post_w": 1.0 + 0.05 * n(ks[13], (L, D_MODEL), f),
        "w_up": n(ks[14], (L, D_MODEL, 2 * D_FF), f) * D_MODEL ** -0.5,
        "ffn_conv_w": n(ks[15], (L, CONV_K, 2 * D_FF), f) * CONV_K ** -0.5,
        "w_down": n(ks[16], (L, D_FF, D_MODEL), f) * D_FF ** -0.5,
    }


def reference(x, c, w_mod, b_mod, mix_pre_w, mix_post_w, w_in, conv_w, gate_w2, gate_b, gla_norm_w,
              w_out, ffn_pre_w, ffn_post_w, w_up, ffn_conv_w, w_down):
    c_act = jax.nn.silu(c)
    for l in range(DEPTH):
        mod = (c_act @ w_mod[l] + b_mod[l])[:, None, :]
        sh_m, sc_m, g_m, sh_f, sc_f, g_f = jnp.split(mod, 6, axis=-1)
        h = rmsnorm(x, mix_pre_w[l]) * (1 + sc_m) + sh_m
        y = hybrid_mixer(h, w_in[l], conv_w[l], gate_w2[l], gate_b[l], gla_norm_w[l], w_out[l])
        x = x + g_m * rmsnorm(y, mix_post_w[l])
        h = rmsnorm(x, ffn_pre_w[l]) * (1 + sc_f) + sh_f
        y = conv_ffn(h, w_up[l], ffn_conv_w[l], w_down[l])
        x = x + g_f * rmsnorm(y, ffn_post_w[l])
    return x
```

```cpp
#include <hip/hip_runtime.h>
#include <hip/hip_cooperative_groups.h>
#include <cstdio>
#include <cstdint>
namespace cg = cooperative_groups;
namespace pg8 {
#define PG8_LAS __attribute__((address_space(3)))
typedef unsigned short bf16_t;
typedef short bf16x8 __attribute__((ext_vector_type(8)));
typedef float f32x4 __attribute__((ext_vector_type(4)));
typedef unsigned u32x4 __attribute__((ext_vector_type(4)));
typedef unsigned u32x2 __attribute__((ext_vector_type(2)));
typedef float f32x2 __attribute__((ext_vector_type(2)));
constexpr int BM = 256, BK = 64, HALF = 128, HTB = HALF * BK * 2  , STAGE_BYTES = 8 * HTB, NXCD = 8, WGM = 8;

__host__ __device__ __forceinline__ int lds_byte(int r, int c) { const int st = (r >> 4) * 2 + (c >> 5), rr = r & 15, cc = c & 31, ob = rr * 64 + cc * 2; return st * 1024 + (ob ^ (((ob >> 9) & 1) << 5)); }
__host__ __device__ __forceinline__ void stage_rc(int b, int& R, int& C) { const int st = b / 1024, sb = b % 1024, swz = sb ^ (((sb >> 9) & 1) << 5); R = (st >> 1) * 16 + swz / 64; C = (st & 1) * 32 + (swz % 64) / 2; }
__host__ __device__ __forceinline__ int perm32(int rho) { const int n = rho >> 4, i = rho & 15; return 8 * (i >> 2) + 4 * n + (i & 3); }

struct Unit { int pm, pn; };
struct Gemm { const bf16_t* A; const bf16_t* Bt; int M, N, K; };

struct StaticOrder {
    int nM, nN, nwg, G, c;
    __host__ __device__ void init(int M, int N, int G_, int c_) { nM = M / BM; nN = N / BM; nwg = nM * nN; G = G_; c = c_; }
    __host__ __device__ bool next(int i, Unit& u) const {
        const long L = (long)i * G + c; if (L >= nwg) return false;
        int wgid = (int)L; { const int q = nwg / NXCD, r = nwg % NXCD, xcd = wgid % NXCD, off = wgid / NXCD; wgid = (xcd < r ? xcd * (q + 1) : r * (q + 1) + (xcd - r) * q) + off; }
        const int nig = WGM * nN, gid = wgid / nig, fm = gid * WGM, gsz = (nM - fm) < WGM ? (nM - fm) : WGM;
        u.pm = fm + ((wgid % nig) % gsz); u.pn = (wgid % nig) / gsz; return true;
    }
    __device__ __forceinline__ void a_ready(const Unit&) const {}
    __device__ __forceinline__ void done(const Unit&) const {}
};

__device__ __forceinline__ unsigned cvt_pk_bf16(float lo, float hi) { unsigned r; asm volatile("v_cvt_pk_bf16_f32 %0, %1, %2" : "=v"(r) : "v"(lo), "v"(hi)); return r; }
typedef float cvt_f32x2_t __attribute__((ext_vector_type(2))); typedef __bf16 cvt_bf16x2_t __attribute__((ext_vector_type(2)));
__device__ __forceinline__ unsigned cvt_pk_bf16_safe(float lo, float hi) { cvt_f32x2_t v = {lo, hi}; cvt_bf16x2_t b = __builtin_convertvector(v, cvt_bf16x2_t); return __builtin_bit_cast(unsigned, b); }
#define PG8_MFMA_SETTLE() asm volatile("s_nop 7\n\ts_nop 7\n\ts_nop 7" ::: "memory")
struct EpiB16 {
    static constexpr bool PERM = true, AFTER_DRAIN = false;
    bf16_t* O; int ldc;
    __device__ __forceinline__ void operator()(const f32x4 (&acc)[2][2][4][2], const Unit& u, int wr, int wc, int fr, int fq) const {
        PG8_MFMA_SETTLE();
        const int row0 = u.pm * BM + wr * 64 + fr, col0 = u.pn * BM + wc * 32 + 8 * fq;
#pragma unroll
        for (int ai = 0; ai < 2; ++ai)
#pragma unroll
            for (int m = 0; m < 4; ++m) { bf16_t* rowp = O + (size_t)(row0 + ai * HALF + m * 16) * ldc + col0;
#pragma unroll
                for (int bj = 0; bj < 2; ++bj) { const f32x4 v0 = acc[ai][bj][m][0], v1 = acc[ai][bj][m][1];
                    u32x4 w; w.x = cvt_pk_bf16(v0[0], v0[1]); w.y = cvt_pk_bf16(v0[2], v0[3]); w.z = cvt_pk_bf16(v1[0], v1[1]); w.w = cvt_pk_bf16(v1[2], v1[3]);
                    *(u32x4*)(rowp + bj * HALF) = w; } }
    }
};
struct EpiProj {
    static constexpr bool PERM = true, AFTER_DRAIN = false;
    bf16_t* O; float* alr;
    __device__ __forceinline__ void operator()(const f32x4 (&acc)[2][2][4][2], const Unit& u, int wr, int wc, int fr, int fq) const {
        PG8_MFMA_SETTLE();
        const int row0 = u.pm * BM + wr * 64 + fr;
        if (u.pn < 24) {
            const int col0 = u.pn * BM + wc * 32 + 8 * fq;
#pragma unroll
            for (int ai = 0; ai < 2; ++ai)
#pragma unroll
                for (int m = 0; m < 4; ++m) { bf16_t* rowp = O + (size_t)(row0 + ai * HALF + m * 16) * 6144 + col0;
#pragma unroll
                    for (int bj = 0; bj < 2; ++bj) { const f32x4 v0 = acc[ai][bj][m][0], v1 = acc[ai][bj][m][1];
                        u32x4 w; w.x = cvt_pk_bf16(v0[0], v0[1]); w.y = cvt_pk_bf16(v0[2], v0[3]); w.z = cvt_pk_bf16(v1[0], v1[1]); w.w = cvt_pk_bf16(v1[2], v1[3]);
                        *(u32x4*)(rowp + bj * HALF) = w; } }
        } else if (wc == 0 && fq < 2) {
#pragma unroll
            for (int ai = 0; ai < 2; ++ai)
#pragma unroll
                for (int m = 0; m < 4; ++m) { float* rp = alr + (size_t)(row0 + ai * HALF + m * 16) * 16 + 8 * fq;
                    *(f32x4*)rp = acc[ai][0][m][0]; *(f32x4*)(rp + 4) = acc[ai][0][m][1]; }
        }
    }
};

template <int CTRL> __device__ __forceinline__ float dpp_ror(float v) { return __builtin_bit_cast(float, __builtin_amdgcn_update_dpp(0, __builtin_bit_cast(int, v), CTRL, 0xf, 0xf, false)); }
struct EpiConvGate {
    static constexpr bool PERM = true, AFTER_DRAIN = false;
    bf16_t* ACT; bf16_t* HALO; const float* cw;
    __device__ __forceinline__ void operator()(const f32x4 (&acc)[2][2][4][2], const Unit& u, int wr, int wc, int fr, int fq) const {
        PG8_MFMA_SETTLE();
        constexpr int NUPc = 11264, DFFc = 5632;
        const int j0 = u.pn * 128 + wc * 32 + 8 * fq;
        const int ucol = u.pn * BM + wc * 32 + 8 * fq;
        f32x4 wg[2][3], wv[2][3];
#pragma unroll
        for (int k = 0; k < 3; ++k) { wg[0][k] = *(const f32x4*)(cw + k * NUPc + j0); wv[0][k] = *(const f32x4*)(cw + k * NUPc + DFFc + j0); }
#pragma unroll
        for (int ai = 0; ai < 2; ++ai) {
            const int grp = u.pm * 4 + ai * 2 + wr;
            if (fr < 2 || fr >= 14) { const int rr = fr < 2 ? fr : fr - 12; bf16_t* hp = HALO + ((size_t)grp * 4 + rr) * NUPc + ucol;
#pragma unroll
                for (int bj = 0; bj < 2; ++bj) { const f32x4 v0 = fr < 2 ? acc[ai][bj][0][0] : acc[ai][bj][3][0], v1 = fr < 2 ? acc[ai][bj][0][1] : acc[ai][bj][3][1];
                    u32x4 w; w.x = cvt_pk_bf16(v0[0], v0[1]); w.y = cvt_pk_bf16(v0[2], v0[3]); w.z = cvt_pk_bf16(v1[0], v1[1]); w.w = cvt_pk_bf16(v1[2], v1[3]);
                    *(u32x4*)(hp + bj * HALF) = w; } }
        }
#pragma unroll
        for (int n = 0; n < 2; ++n) {
            if (n == 1) {
                asm volatile("" ::: "memory"); __builtin_amdgcn_sched_barrier(0);
#pragma unroll
                for (int k = 0; k < 3; ++k) { wg[1][k] = *(const f32x4*)(cw + k * NUPc + j0 + 4); wv[1][k] = *(const f32x4*)(cw + k * NUPc + DFFc + j0 + 4); } }
#pragma unroll
            for (int ai = 0; ai < 2; ++ai) {
                __builtin_amdgcn_sched_barrier(0);
                const int jc = j0 + 4 * n;
                f32x2 o[4][2];
#pragma unroll
                for (int xp = 0; xp < 2; ++xp) {
                    const f32x2 a0 = (f32x2){wg[n][0][2 * xp], wg[n][0][2 * xp + 1]}, a1 = (f32x2){wg[n][1][2 * xp], wg[n][1][2 * xp + 1]}, a2 = (f32x2){wg[n][2][2 * xp], wg[n][2][2 * xp + 1]};
                    const f32x2 b0 = (f32x2){wv[n][0][2 * xp], wv[n][0][2 * xp + 1]}, b1 = (f32x2){wv[n][1][2 * xp], wv[n][1][2 * xp + 1]}, b2 = (f32x2){wv[n][2][2 * xp], wv[n][2][2 * xp + 1]};
                    f32x2 g1p = (f32x2){0.f, 0.f}, g2p = g1p, v1p = g1p, v2p = g1p;
#pragma unroll
                    for (int m = 0; m < 4; ++m) {
                        const f32x2 g = (f32x2){acc[ai][0][m][n][2 * xp], acc[ai][0][m][n][2 * xp + 1]}, v = (f32x2){acc[ai][1][m][n][2 * xp], acc[ai][1][m][n][2 * xp + 1]};
                        f32x2 g1, g2, v1, v2, ga, gb, va, vb;
#pragma unroll
                        for (int c = 0; c < 2; ++c) { g1[c] = dpp_ror<0x121>(g[c]); g2[c] = dpp_ror<0x122>(g[c]); v1[c] = dpp_ror<0x121>(v[c]); v2[c] = dpp_ror<0x122>(v[c]);
                            ga[c] = fr == 0 ? g1p[c] : g1[c]; gb[c] = fr < 2 ? g2p[c] : g2[c]; va[c] = fr == 0 ? v1p[c] : v1[c]; vb[c] = fr < 2 ? v2p[c] : v2[c]; }
                        const f32x2 G = a0 * gb + a1 * ga + a2 * g, V = b0 * vb + b1 * va + b2 * v;
                        const f32x2 t = G * (-1.4426950408889634f);
                        f32x2 e; e.x = __builtin_amdgcn_exp2f(t.x); e.y = __builtin_amdgcn_exp2f(t.y);
                        const f32x2 dn = e + 1.0f;
                        f32x2 rc; rc.x = __builtin_amdgcn_rcpf(dn.x); rc.y = __builtin_amdgcn_rcpf(dn.y);
                        o[m][xp] = (G * rc) * V;
                        g1p = g1; g2p = g2; v1p = v1; v2p = v2;
                    }
                }
#pragma unroll
                for (int m = 0; m < 4; ++m) { const int row = u.pm * BM + ai * HALF + wr * 64 + m * 16 + fr;
                    u32x2 w; w.x = cvt_pk_bf16(o[m][0].x, o[m][0].y); w.y = cvt_pk_bf16(o[m][1].x, o[m][1].y);
                    if (m > 0 || fr >= 2) *(u32x2*)(ACT + (size_t)row * DFFc + jc) = w; }
            }
        }
    }
};

template <class Epi, class Sched, bool ALIGN_EPI = false, bool SP2 = false>
__device__ __forceinline__ void gemm_phase(PG8_LAS unsigned char* lds, const Gemm g, const Sched& S, const Epi& E) {
    const int tid = threadIdx.x, wid = __builtin_amdgcn_readfirstlane(tid >> 6), lane = tid & 63, wr = wid >> 2, wc = wid & 3, fr = lane & 15, fq = lane >> 4;
    const int K = g.K, nt = K / BK;
    unsigned voffA[2], voffB[2];
#pragma unroll
    for (int i = 0; i < 2; ++i) { int R, C; stage_rc(tid * 16 + i * 8192, R, C); const int Rb = Epi::PERM ? ((R & ~31) + perm32(R & 31)) : R;
        voffA[i] = (unsigned)(R * K + C) * 2u; voffB[i] = (unsigned)(Rb * K + C) * 2u; }
    const size_t kstep = (size_t)(BK * 2);
    const size_t hstep = (size_t)HALF * K * 2;
    const size_t tstep = 2 * hstep;
    const unsigned ldsw = (unsigned)wid * 1024u;
    const int aoff = lds_byte(wr * 64 + fr, fq * 8), boff = lds_byte(wc * 32 + fr, fq * 8);
#define PG8_SA(b, h) (((b) * 2 + (h)) * HTB)
#define PG8_SB(b, h) ((4 + (b) * 2 + (h)) * HTB)
#define PG8_STAGE(bufoff, gbase, voff) do { _Pragma("unroll") for (int _i = 0; _i < 2; ++_i) \
        __builtin_amdgcn_global_load_lds((const unsigned*)((const char*)(gbase) + (voff)[_i]), (PG8_LAS unsigned*)(lds + (bufoff) + ldsw + _i * 8192), 16, 0, 0); } while (0)
#define PG8_LDA(dst, b, h) do { _Pragma("unroll") for (int m = 0; m < 4; ++m) _Pragma("unroll") for (int k = 0; k < 2; ++k) dst[m][k] = *(const PG8_LAS bf16x8*)(lds + PG8_SA(b, h) + aoff + m * 2048 + k * 1024); } while (0)
#define PG8_LDB(dst, b, h) do { _Pragma("unroll") for (int n = 0; n < 2; ++n) _Pragma("unroll") for (int k = 0; k < 2; ++k) dst[n][k] = *(const PG8_LAS bf16x8*)(lds + PG8_SB(b, h) + boff + n * 2048 + k * 1024); } while (0)
#define PG8_MMA(ai, bj, At, Bt) do { __builtin_amdgcn_s_setprio(1); _Pragma("unroll") for (int m = 0; m < 4; ++m) _Pragma("unroll") for (int n = 0; n < 2; ++n) _Pragma("unroll") for (int k = 0; k < 2; ++k) \
        acc[ai][bj][m][n] = __builtin_amdgcn_mfma_f32_16x16x32_bf16(Bt[n][k], At[m][k], acc[ai][bj][m][n], 0, 0, 0); __builtin_amdgcn_s_setprio(0); } while (0)
#define PG8_WAIT_V(n) asm volatile("s_waitcnt vmcnt(" #n ")" ::: "memory")
#define PG8_WAIT_L(n) asm volatile("s_waitcnt lgkmcnt(" #n ")" ::: "memory")
#define PG8_BAR __builtin_amdgcn_s_barrier()
#define PG8_SCHED __builtin_amdgcn_sched_barrier(0)
    Unit cur, nxt; int ui = 0;
    if (!S.next(0, cur)) return;
    f32x4 acc[2][2][4][2];
#pragma unroll
    for (int a = 0; a < 2; ++a)
#pragma unroll
        for (int b = 0; b < 2; ++b)
#pragma unroll
            for (int m = 0; m < 4; ++m)
#pragma unroll
                for (int n = 0; n < 2; ++n) acc[a][b][m][n] = (f32x4){0.f, 0.f, 0.f, 0.f};
    bf16x8 At[4][2], B0[2][2], B1[2][2];
    const char* cA = (const char*)g.A + (size_t)cur.pm * tstep; const char* cB = (const char*)g.Bt + (size_t)cur.pn * tstep;
    S.a_ready(cur);
    if constexpr (SP2) {
        PG8_STAGE(PG8_SB(0, 0), cB, voffB); PG8_STAGE(PG8_SB(0, 1), cB + hstep, voffB); PG8_STAGE(PG8_SA(0, 0), cA, voffA); PG8_STAGE(PG8_SA(0, 1), cA + hstep, voffA);
        if (wr == 1) PG8_BAR;
        PG8_WAIT_V(2); PG8_BAR;
        PG8_STAGE(PG8_SB(1, 0), cB + kstep, voffB); PG8_STAGE(PG8_SA(1, 0), cA + kstep, voffA); PG8_STAGE(PG8_SB(1, 1), cB + hstep + kstep, voffB);
        PG8_WAIT_V(6); PG8_BAR;
    } else {
        PG8_STAGE(PG8_SB(0, 0), cB, voffB); PG8_STAGE(PG8_SA(0, 0), cA, voffA); PG8_STAGE(PG8_SB(0, 1), cB + hstep, voffB); PG8_STAGE(PG8_SA(0, 1), cA + hstep, voffA);
        if (wr == 1) PG8_BAR;
        PG8_WAIT_V(4); PG8_BAR;
        PG8_STAGE(PG8_SB(1, 0), cB + kstep, voffB); PG8_STAGE(PG8_SA(1, 0), cA + kstep, voffA); PG8_STAGE(PG8_SB(1, 1), cB + hstep + kstep, voffB);
        PG8_WAIT_V(6); PG8_BAR;
    }
    for (;;) {
        const bool has_next = S.next(ui + 1, nxt);
        const char* nA = has_next ? (const char*)g.A + (size_t)nxt.pm * tstep : cA; const char* nB = has_next ? (const char*)g.Bt + (size_t)nxt.pn * tstep : cB;
        for (int t = 0; t < nt; t += 2) {
            const bool last = (t == nt - 2);
            const char* a1 = cA + (size_t)(t + 1) * kstep;
            const char* a2 = last ? nA : cA + (size_t)(t + 2) * kstep; const char* b2 = last ? nB : cB + (size_t)(t + 2) * kstep;
            const char* a3 = a2 + kstep; const char* b3 = b2 + kstep;
            if (last && has_next) S.a_ready(nxt);
            if constexpr (SP2) {
            PG8_LDB(B0, 0, 0); PG8_LDB(B1, 0, 1); PG8_SCHED; PG8_LDA(At, 0, 0); PG8_STAGE(PG8_SA(1, 1), a1 + hstep, voffA);
            PG8_WAIT_V(8); PG8_WAIT_L(0); PG8_BAR; PG8_MMA(0, 0, At, B0); PG8_MMA(0, 1, At, B1); PG8_BAR; PG8_SCHED;
            PG8_LDA(At, 0, 1); PG8_STAGE(PG8_SB(0, 0), b2, voffB); PG8_STAGE(PG8_SB(0, 1), b2 + hstep, voffB); PG8_STAGE(PG8_SA(0, 0), a2, voffA);
            PG8_WAIT_V(8); PG8_WAIT_L(0); PG8_BAR; PG8_MMA(1, 0, At, B0); PG8_MMA(1, 1, At, B1); PG8_BAR; PG8_SCHED;
            PG8_LDB(B0, 1, 0); PG8_LDB(B1, 1, 1); PG8_SCHED; PG8_LDA(At, 1, 0); PG8_STAGE(PG8_SA(0, 1), a2 + hstep, voffA);
            PG8_WAIT_V(8); PG8_WAIT_L(0); PG8_BAR; PG8_MMA(0, 0, At, B0); PG8_MMA(0, 1, At, B1); PG8_BAR; PG8_SCHED;
            PG8_LDA(At, 1, 1); PG8_STAGE(PG8_SB(1, 0), b3, voffB); PG8_STAGE(PG8_SB(1, 1), b3 + hstep, voffB); PG8_STAGE(PG8_SA(1, 0), a3, voffA);
            PG8_WAIT_V(8); PG8_WAIT_L(0); PG8_BAR; PG8_MMA(1, 0, At, B0); PG8_MMA(1, 1, At, B1); PG8_BAR; PG8_SCHED;
            } else {
            PG8_LDB(B0, 0, 0); PG8_SCHED; PG8_LDA(At, 0, 0); PG8_STAGE(PG8_SA(1, 1), a1 + hstep, voffA);
            PG8_WAIT_L(8); PG8_BAR; PG8_WAIT_L(0); PG8_MMA(0, 0, At, B0); PG8_BAR; PG8_SCHED;
            PG8_LDB(B1, 0, 1); PG8_STAGE(PG8_SB(0, 0), b2, voffB);
            PG8_BAR; PG8_WAIT_L(0); PG8_MMA(0, 1, At, B1); PG8_BAR;
            PG8_LDA(At, 0, 1); PG8_STAGE(PG8_SA(0, 0), a2, voffA);
            PG8_BAR; PG8_WAIT_L(0); PG8_MMA(1, 0, At, B0); PG8_BAR; PG8_SCHED;
            PG8_STAGE(PG8_SB(0, 1), b2 + hstep, voffB);
            PG8_WAIT_V(6); PG8_BAR; PG8_MMA(1, 1, At, B1); PG8_BAR;
            PG8_LDB(B0, 1, 0); PG8_SCHED; PG8_LDA(At, 1, 0); PG8_STAGE(PG8_SA(0, 1), a2 + hstep, voffA);
            PG8_WAIT_L(8); PG8_BAR; PG8_WAIT_L(0); PG8_MMA(0, 0, At, B0); PG8_BAR; PG8_SCHED;
            PG8_LDB(B1, 1, 1); PG8_STAGE(PG8_SB(1, 0), b3, voffB);
            PG8_BAR; PG8_WAIT_L(0); PG8_MMA(0, 1, At, B1); PG8_BAR;
            PG8_LDA(At, 1, 1); PG8_STAGE(PG8_SA(1, 0), a3, voffA);
            PG8_BAR; PG8_WAIT_L(0); PG8_MMA(1, 0, At, B0); PG8_BAR; PG8_SCHED;
            PG8_STAGE(PG8_SB(1, 1), b3 + hstep, voffB);
            PG8_WAIT_V(6); PG8_BAR; PG8_MMA(1, 1, At, B1); PG8_BAR;
            }
        }
        if constexpr (ALIGN_EPI) { if (wr == 0) PG8_BAR; }
        if constexpr (!Epi::AFTER_DRAIN) { E(acc, cur, wr, wc, fr, fq); S.done(cur); }
        if (!has_next) break;
#pragma unroll
        for (int a = 0; a < 2; ++a)
#pragma unroll
            for (int b = 0; b < 2; ++b)
#pragma unroll
                for (int m = 0; m < 4; ++m)
#pragma unroll
                    for (int n = 0; n < 2; ++n) acc[a][b][m][n] = (f32x4){0.f, 0.f, 0.f, 0.f};
        cur = nxt; cA = nA; cB = nB; ++ui;
        if constexpr (ALIGN_EPI) { if (wr == 1) PG8_BAR; }
    }
    PG8_WAIT_V(0);
    if constexpr (!ALIGN_EPI) { if (wr == 0) PG8_BAR; }
    PG8_BAR;
    if constexpr (Epi::AFTER_DRAIN) { E.fused(acc, cur, wr, wc, fr, fq, lds, wid, lane); S.done(cur); }
#undef PG8_SA
#undef PG8_SB
#undef PG8_STAGE
#undef PG8_LDA
#undef PG8_LDB
#undef PG8_MMA
#undef PG8_WAIT_V
#undef PG8_WAIT_L
#undef PG8_BAR
#undef PG8_SCHED
}
}

constexpr int NWAVES = 8, NT = 512;
constexpr int SEQ = 16384, M = 32768, D = 2048, NIN = 6144, NINP = 6400, NIN_SRC = 6160, DFF = 5632, NUP = 11264, MH = 16384;
constexpr int C_CB = 0, C_CC = 1024, C_CX = 2048, C_Q = 3072, C_K = 3584, C_V = 4096, C_R = 5120;
constexpr float EPS = 1e-6f;
constexpr size_t MiB = 1u << 20;
constexpr size_t WS_MOD = 1 * MiB;
constexpr size_t WS_WIN = 2 * MiB, WS_WOUT = 27 * MiB, WS_WUP = 35 * MiB, WS_WDN = 79 * MiB;
constexpr size_t WS_H = 104 * MiB;
constexpr size_t WS_PROJ = 232 * MiB;
constexpr size_t WS_ALR = 616 * MiB;
constexpr size_t WS_S = 618 * MiB;
constexpr size_t WS_DEC = 746 * MiB;
constexpr size_t WS_Y = 748 * MiB;
constexpr size_t WS_HALO = 232 * MiB;
constexpr size_t WS_ACT = 584 * MiB;
constexpr size_t WS_Y2 = 232 * MiB;
constexpr size_t WS_END = 936 * MiB;
constexpr int LDS_BYTES = 147456;

#define GAS __attribute__((address_space(1)))
#define LAS __attribute__((address_space(3)))
typedef unsigned short bf16;
typedef unsigned v4u __attribute__((ext_vector_type(4)));
typedef unsigned v2u __attribute__((ext_vector_type(2)));
typedef float f32x4 __attribute__((ext_vector_type(4)));
typedef float f32x2 __attribute__((ext_vector_type(2)));
typedef short bf16x8 __attribute__((ext_vector_type(8)));
#define LDS_WAIT() asm volatile("s_waitcnt lgkmcnt(0)" ::: "memory")

__device__ __forceinline__ unsigned pk2(float lo, float hi) { return pg8::cvt_pk_bf16_safe(lo, hi); }
__device__ __forceinline__ float bflo(unsigned w) { return __uint_as_float(w << 16); }
__device__ __forceinline__ float bfhi(unsigned w) { return __uint_as_float(w & 0xffff0000u); }
__device__ __forceinline__ float bf1(bf16 b) { return __uint_as_float(((unsigned)b) << 16); }
__device__ __forceinline__ float silu_f(float v) { return v / (1.0f + __expf(-v)); }
__device__ __forceinline__ float wave_sum(float v) {
#pragma unroll
    for (int o = 1; o < 64; o <<= 1) v += __shfl_xor(v, o);
    return v;
}
__device__ __forceinline__ void unpack8(const v4u w, float (&f)[8]) {
    f[0] = bflo(w.x); f[1] = bfhi(w.x); f[2] = bflo(w.y); f[3] = bfhi(w.y); f[4] = bflo(w.z); f[5] = bfhi(w.z); f[6] = bflo(w.w); f[7] = bfhi(w.w);
}
__device__ __forceinline__ v4u pack8(const float (&f)[8]) { v4u w; w.x = pk2(f[0], f[1]); w.y = pk2(f[2], f[3]); w.z = pk2(f[4], f[5]); w.w = pk2(f[6], f[7]); return w; }

struct Args { const float* in[17]; float* out; unsigned char* ws; int ph_lo, ph_hi; };
enum { I_X = 0, I_C, I_WMOD, I_BMOD, I_MIXPRE, I_MIXPOST, I_WIN, I_CONVW, I_GW2, I_GB, I_GNW, I_WOUT, I_FPRE, I_FPOST, I_WUP, I_FCONVW, I_WDN };

__device__ __forceinline__ void transpose_item(const float* W, int K, int N, int k0, int n0, int ncols, bf16* WT, int drow0, LAS float* scr, int lane) {
    const int cl = lane & 31; const bool cv = cl < ncols;
#pragma unroll 8
    for (int i = 0; i < 32; ++i) { const int kk = 2 * i + (lane >> 5); scr[kk * 33 + cl] = cv ? W[(size_t)(k0 + kk) * N + n0 + cl] : 0.f; }
    LDS_WAIT(); asm volatile("" ::: "memory");
    const int c = lane & 7;
#pragma unroll
    for (int j = 0; j < 4; ++j) { const int n = (lane >> 3) + 8 * j; const LAS float* s = scr + (8 * c) * 33 + n;
        v4u o; o.x = pk2(s[0 * 33], s[1 * 33]); o.y = pk2(s[2 * 33], s[3 * 33]); o.z = pk2(s[4 * 33], s[5 * 33]); o.w = pk2(s[6 * 33], s[7 * 33]);
        if (n < ncols) *(v4u*)(WT + (size_t)(drow0 + n) * K + k0 + 8 * c) = o; }
    LDS_WAIT(); asm volatile("" ::: "memory");
}

__device__ __forceinline__ void phase_prologue(const Args& a, LAS unsigned char* lds, int tid, int lane, int wave) {
    unsigned char* ws = a.ws;
    if (blockIdx.x < 192) {
        LAS float* ca = (LAS float*)lds;
        LAS float* red = (LAS float*)(lds + 16384);
        const float* c = a.in[I_C];
        for (int i = tid; i < 4096; i += NT) ca[i] = silu_f(c[i]);
        __syncthreads();
        const int col = blockIdx.x * 64 + lane; const float* wm = a.in[I_WMOD] + col;
        float a0 = 0.f, a1 = 0.f;
        for (int k0 = wave * 256; k0 < wave * 256 + 256; k0 += 32) {
            float wv[32];
#pragma unroll
            for (int i = 0; i < 32; ++i) wv[i] = wm[(size_t)(k0 + i) * 12288];
#pragma unroll
            for (int i = 0; i < 32; ++i) { a0 += ca[k0 + i] * wv[i]; a1 += ca[2048 + k0 + i] * wv[i]; } }
        red[(wave * 2 + 0) * 64 + lane] = a0; red[(wave * 2 + 1) * 64 + lane] = a1;
        __syncthreads();
        if (tid < 128) { const int b = tid >> 6, l = tid & 63; float s = 0.f;
#pragma unroll
            for (int w = 0; w < 8; ++w) s += red[(w * 2 + b) * 64 + l];
            const int cc = blockIdx.x * 64 + l; ((float*)(ws + WS_MOD))[b * 12288 + cc] = s + a.in[I_BMOD][cc]; }
        __syncthreads();
    }
    LAS float* scr = (LAS float*)(lds + wave * 16384);
    const int gw = blockIdx.x * NWAVES + wave, NGW = gridDim.x * NWAVES;
    constexpr int IT_IN = 32 * 193, IT_OUT = 32 * 64, IT_UP = 32 * 352, IT_DN = 88 * 64;
    for (int it = gw; it < IT_IN + IT_OUT + IT_UP + IT_DN; it += NGW) {
        int r = it;
        if (r < IT_IN) { const int kb = r / 193, nb = r % 193; transpose_item(a.in[I_WIN], D, NIN_SRC, 64 * kb, 32 * nb, nb == 192 ? 16 : 32, (bf16*)(ws + WS_WIN), 32 * nb, scr, lane); continue; } r -= IT_IN;
        if (r < IT_OUT) { const int kb = r / 64, nb = r % 64; transpose_item(a.in[I_WOUT], D, D, 64 * kb, 32 * nb, 32, (bf16*)(ws + WS_WOUT), 32 * nb, scr, lane); continue; } r -= IT_OUT;
        if (r < IT_UP) { const int kb = r / 352, nb = r % 352; const int n0 = 32 * nb; const int jj = n0 < DFF ? n0 : n0 - DFF;
            const int drow = 256 * (jj >> 7) + (n0 < DFF ? 0 : 128) + (jj & 127);
            transpose_item(a.in[I_WUP], D, NUP, 64 * kb, n0, 32, (bf16*)(ws + WS_WUP), drow, scr, lane); continue; } r -= IT_UP;
        { const int kb = r / 64, nb = r % 64; transpose_item(a.in[I_WDN], DFF, D, 64 * kb, 32 * nb, 32, (bf16*)(ws + WS_WDN), 32 * nb, scr, lane); }
    }
}

__device__ __forceinline__ void phase_h1(const Args& a, int lane, int wave) {
    const float* mod = (const float*)(a.ws + WS_MOD); bf16* H = (bf16*)(a.ws + WS_H);
    const int NGW = gridDim.x * NWAVES;
    for (int rb = blockIdx.x * NWAVES + wave; rb < M / 16; rb += NGW) {
        const int m0 = rb * 16, b = m0 >> 14; const float* mb = mod + b * 12288;
        float A[4][8], B[4][8];
#pragma unroll
        for (int j = 0; j < 4; ++j)
#pragma unroll
            for (int e = 0; e < 8; ++e) { const int col = 512 * j + 8 * lane + e; A[j][e] = a.in[I_MIXPRE][col] * (1.0f + mb[2048 + col]); B[j][e] = mb[col]; }
        for (int r = 0; r < 16; ++r) {
            const float* xr = a.in[I_X] + (size_t)(m0 + r) * D + 8 * lane;
            f32x4 v[4][2]; float ss = 0.f;
#pragma unroll
            for (int j = 0; j < 4; ++j) { v[j][0] = *(const f32x4*)(xr + 512 * j); v[j][1] = *(const f32x4*)(xr + 512 * j + 4); }
#pragma unroll
            for (int j = 0; j < 4; ++j)
#pragma unroll
                for (int q = 0; q < 2; ++q) ss += (v[j][q].x * v[j][q].x + v[j][q].y * v[j][q].y) + (v[j][q].z * v[j][q].z + v[j][q].w * v[j][q].w);
            const float rstd = rsqrtf(wave_sum(ss) * (1.0f / D) + EPS);
            bf16* hr = H + (size_t)(m0 + r) * D + 8 * lane;
#pragma unroll
            for (int j = 0; j < 4; ++j) { float o[8];
#pragma unroll
                for (int e = 0; e < 8; ++e) o[e] = v[j][e >> 2][e & 3] * rstd * A[j][e] + B[j][e];
                *(v4u*)(hr + 512 * j) = pack8(o); }
        }
        asm volatile("s_waitcnt vmcnt(0)" ::: "memory");
        { const int r16 = lane & 15, q4 = lane >> 4;
          const bf16* hrow = H + (size_t)(m0 + r16) * D + 8 * q4; const bf16* wrow = (const bf16*)(a.ws + WS_WIN) + (size_t)(NIN + r16) * D + 8 * q4;
          f32x4 acc0 = (f32x4){0.f, 0.f, 0.f, 0.f}, acc1 = acc0;
#pragma unroll 4
          for (int ks = 0; ks < 64; ks += 2) {
              const bf16x8 a0 = *(const bf16x8*)(hrow + 32 * ks), b0 = *(const bf16x8*)(wrow + 32 * ks), a1 = *(const bf16x8*)(hrow + 32 * ks + 32), b1 = *(const bf16x8*)(wrow + 32 * ks + 32);
              acc0 = __builtin_amdgcn_mfma_f32_16x16x32_bf16(a0, b0, acc0, 0, 0, 0); acc1 = __builtin_amdgcn_mfma_f32_16x16x32_bf16(a1, b1, acc1, 0, 0, 0); }
          float* alr = (float*)(a.ws + WS_ALR);
#pragma unroll
          for (int x = 0; x < 4; ++x) alr[(size_t)(m0 + 4 * q4 + x) * 16 + r16] = acc0[x] + acc1[x]; }
    }
}

struct GateIn { f32x4 av; float w2r[16]; float gb; };
__device__ __forceinline__ void gates_load(const Args& a, int m0, int h, int tid, GateIn& g) {
    const float* alr = (const float*)(a.ws + WS_ALR) + (size_t)m0 * 16;
    g.av = (f32x4){0.f, 0.f, 0.f, 0.f};
    if (tid < 256) g.av = *(const f32x4*)(alr + 4 * tid);
    const int d = tid & 127;
#pragma unroll
    for (int r = 0; r < 16; ++r) g.w2r[r] = a.in[I_GW2][r * 512 + h * 128 + d];
    g.gb = a.in[I_GB][h * 128 + d];
}
__device__ __forceinline__ void gates_compute(const GateIn& g, LAS float* aL, LAS float* tot, int tid, float (&bq)[16], float& blast) {
    if (tid < 256) *(LAS f32x4*)(aL + 4 * tid) = g.av;
    const int d = tid & 127, ig = tid >> 7;
    __syncthreads();
    float run = 0.f;
#pragma unroll
    for (int ii = 0; ii < 16; ++ii) { const LAS f32x4* ar = (const LAS f32x4*)(aL + (16 * ig + ii) * 16); float z = g.gb;
#pragma unroll
        for (int r4 = 0; r4 < 4; ++r4) { const f32x4 av = ar[r4]; z += av.x * g.w2r[4 * r4] + av.y * g.w2r[4 * r4 + 1] + av.z * g.w2r[4 * r4 + 2] + av.w * g.w2r[4 * r4 + 3]; }
        const float ls = fminf(z, 0.f) - __logf(1.0f + __expf(-fabsf(z)));
        run += ls * (1.0f / 16.0f); bq[ii] = run; }
    tot[ig * 128 + d] = run;
    __syncthreads();
    float off = 0.f, all = 0.f;
#pragma unroll
    for (int gg = 0; gg < 4; ++gg) { const float t = tot[gg * 128 + d]; all += t; off += (gg < ig) ? t : 0.f; }
#pragma unroll
    for (int ii = 0; ii < 16; ++ii) bq[ii] += off;
    blast = all;
}

__device__ __forceinline__ void phase_g1(const Args& a, LAS unsigned char* lds, int tid, int lane, int wave) {
    LAS float* aL = (LAS float*)lds; LAS float* tot = (LAS float*)(lds + 4096); LAS bf16* kdT = (LAS bf16*)(lds + 8192);
    LAS bf16* Kr = (LAS bf16*)(lds + 26624); LAS bf16* Vs = (LAS bf16*)(lds + 44032);
    const bf16* proj = (const bf16*)(a.ws + WS_PROJ); bf16* S = (bf16*)(a.ws + WS_S); float* dec = (float*)(a.ws + WS_DEC);
    const int d = tid & 127, ig = tid >> 7, r16 = lane & 15, q4 = lane >> 4;
    for (int unit = blockIdx.x; unit < 2048; unit += gridDim.x) {
        const int bh = unit >> 8, n = unit & 255, b = bh >> 2, h = bh & 3, m0 = b * SEQ + n * 64;
        float bq[16], blast;
        GateIn gin; gates_load(a, m0, h, tid, gin);
        v4u kreg[2], vreg[4];
#pragma unroll
        for (int s2 = 0; s2 < 2; ++s2) { const int c = tid + 512 * s2; kreg[s2] = *(const v4u*)(proj + (size_t)(m0 + (c >> 4)) * NIN + C_K + h * 128 + 8 * (c & 15)); }
#pragma unroll
        for (int s4 = 0; s4 < 4; ++s4) { const int c = tid + 512 * s4; vreg[s4] = *(const v4u*)(proj + (size_t)(m0 + (c >> 5)) * NIN + C_V + h * 256 + 8 * (c & 31)); }
        gates_compute(gin, aL, tot, tid, bq, blast);
#pragma unroll
        for (int s2 = 0; s2 < 2; ++s2) { const int c = tid + 512 * s2; *(LAS v4u*)(Kr + (c >> 4) * 136 + 8 * (c & 15)) = kreg[s2]; }
#pragma unroll
        for (int s4 = 0; s4 < 4; ++s4) { const int c = tid + 512 * s4; *(LAS v4u*)(Vs + (c >> 5) * 264 + 8 * (c & 31)) = vreg[s4]; }
        __syncthreads();
        { float kd[16];
#pragma unroll
          for (int ii = 0; ii < 16; ++ii) kd[ii] = bf1(Kr[(16 * ig + ii) * 136 + d]) * __expf(blast - bq[ii]);
          v4u w0, w1; w0.x = pk2(kd[0], kd[1]); w0.y = pk2(kd[2], kd[3]); w0.z = pk2(kd[4], kd[5]); w0.w = pk2(kd[6], kd[7]);
          w1.x = pk2(kd[8], kd[9]); w1.y = pk2(kd[10], kd[11]); w1.z = pk2(kd[12], kd[13]); w1.w = pk2(kd[14], kd[15]);
          *(LAS v4u*)(kdT + d * 72 + 16 * ig) = w0; *(LAS v4u*)(kdT + d * 72 + 16 * ig + 8) = w1;
          if (ig == 0) dec[unit * 128 + d] = __expf(blast); }
        bf16x8 vf[2][2];
#pragma unroll
        for (int nt = 0; nt < 2; ++nt)
#pragma unroll
            for (int ks = 0; ks < 2; ++ks)
#pragma unroll
                for (int jj = 0; jj < 8; ++jj) vf[nt][ks][jj] = (short)Vs[(32 * ks + 8 * q4 + jj) * 264 + 32 * wave + 16 * nt + r16];
        __syncthreads();
        f32x4 acc[8][2];
#pragma unroll
        for (int mt = 0; mt < 8; ++mt)
#pragma unroll
            for (int nt = 0; nt < 2; ++nt) acc[mt][nt] = (f32x4){0.f, 0.f, 0.f, 0.f};
#pragma unroll
        for (int mt = 0; mt < 8; ++mt)
#pragma unroll
            for (int ks = 0; ks < 2; ++ks) { const bf16x8 af = *(const LAS bf16x8*)(kdT + (16 * mt + r16) * 72 + 32 * ks + 8 * q4);
#pragma unroll
                for (int nt = 0; nt < 2; ++nt) acc[mt][nt] = __builtin_amdgcn_mfma_f32_16x16x32_bf16(af, vf[nt][ks], acc[mt][nt], 0, 0, 0); }
        bf16* Su = S + (size_t)unit * 32768;
#pragma unroll
        for (int mt = 0; mt < 8; ++mt)
#pragma unroll
            for (int nt = 0; nt < 2; ++nt) { v2u w; w.x = pk2(acc[mt][nt][0], acc[mt][nt][1]); w.y = pk2(acc[mt][nt][2], acc[mt][nt][3]);
                *(v2u*)(Su + (32 * wave + 16 * nt + r16) * 128 + 16 * mt + 4 * q4) = w; }
        __syncthreads();
    }
    bf16* Y = (bf16*)(a.ws + WS_H);
    for (int item = blockIdx.x; item < M / 64; item += gridDim.x) {
        const int c0 = 8 * (tid & 127), mr = item * 64 + 16 * (tid >> 7);
        float w0[8], w1[8], w2[8], p1[8], p2[8];
#pragma unroll
        for (int e = 0; e < 8; ++e) { w0[e] = a.in[I_CONVW][c0 + e]; w1[e] = a.in[I_CONVW][1024 + c0 + e]; w2[e] = a.in[I_CONVW][2048 + c0 + e]; p1[e] = 0.f; p2[e] = 0.f; }
        if ((mr & (SEQ - 1)) != 0) {
            float c1[8], x1[8]; const bf16* r2 = proj + (size_t)(mr - 2) * NIN + c0; const bf16* r1 = proj + (size_t)(mr - 1) * NIN + c0;
            unpack8(*(const v4u*)(r2 + C_CC), c1); unpack8(*(const v4u*)(r2 + C_CX), x1);
#pragma unroll
            for (int e = 0; e < 8; ++e) p2[e] = c1[e] * x1[e];
            unpack8(*(const v4u*)(r1 + C_CC), c1); unpack8(*(const v4u*)(r1 + C_CX), x1);
#pragma unroll
            for (int e = 0; e < 8; ++e) p1[e] = c1[e] * x1[e];
        }
        for (int r0 = 0; r0 < 16; r0 += 4) {
            v4u rb[4], rc[4], rx[4];
#pragma unroll
            for (int q = 0; q < 4; ++q) { const bf16* rp = proj + (size_t)(mr + r0 + q) * NIN + c0; rb[q] = *(const v4u*)(rp + C_CB); rc[q] = *(const v4u*)(rp + C_CC); rx[q] = *(const v4u*)(rp + C_CX); }
#pragma unroll
            for (int q = 0; q < 4; ++q) { float cb[8], cc[8], cx[8], o[8];
                unpack8(rb[q], cb); unpack8(rc[q], cc); unpack8(rx[q], cx);
#pragma unroll
                for (int e = 0; e < 8; ++e) { const float p0 = cc[e] * cx[e]; o[e] = cb[e] * (w0[e] * p2[e] + w1[e] * p1[e] + w2[e] * p0); p2[e] = p1[e]; p1[e] = p0; }
                *(v4u*)(Y + (size_t)(mr + r0 + q) * D + c0) = pack8(o); }
        }
    }
}

__device__ __forceinline__ void phase_g2(const Args& a, int tid) {
    unsigned* S = (unsigned*)(a.ws + WS_S); const float* dec = (const float*)(a.ws + WS_DEC);
    const int total = gridDim.x * NT;
    for (int idx = blockIdx.x * NT + tid; idx < 8 * 16384; idx += total) {
        const int bh = idx >> 14, r = idx & 16383, d0 = (2 * r) & 127;
        float s0 = 0.f, s1 = 0.f;
        for (int n0 = 0; n0 < 256; n0 += 16) {
            unsigned w[16]; f32x2 dd[16];
#pragma unroll
            for (int i = 0; i < 16; ++i) { const int unit = bh * 256 + n0 + i; w[i] = S[(size_t)unit * 16384 + r]; dd[i] = *(const f32x2*)(dec + unit * 128 + d0); }
#pragma unroll
            for (int i = 0; i < 16; ++i) { const int unit = bh * 256 + n0 + i; S[(size_t)unit * 16384 + r] = pk2(s0, s1);
                s0 = dd[i].x * s0 + bflo(w[i]); s1 = dd[i].y * s1 + bfhi(w[i]); }
        }
    }
}

__device__ __forceinline__ void phase_g3(const Args& a, LAS unsigned char* lds, int tid, int lane, int wave) {
    LAS float* aL = (LAS float*)lds; LAS float* tot = (LAS float*)(lds + 4096); LAS float* part = (LAS float*)(lds + 6144); LAS float* rstdL = (LAS float*)(lds + 8192);
    LAS bf16* Qs = (LAS bf16*)(lds + 8704); LAS bf16* Ks = (LAS bf16*)(lds + 8704 + 17408); LAS bf16* Ps = (LAS bf16*)(lds + 8704 + 2 * 17408);
    LAS bf16* Vs = (LAS bf16*)(lds + 52736); LAS bf16* Rs = (LAS bf16*)(lds + 86528);
    const bf16* proj = (const bf16*)(a.ws + WS_PROJ); const bf16* S = (const bf16*)(a.ws + WS_S); bf16* Y = (bf16*)(a.ws + WS_H);
    const int d = tid & 127, ig = tid >> 7, r16 = lane & 15, q4 = lane >> 4;
    for (int unit = blockIdx.x; unit < 2048; unit += gridDim.x) {
        const int bh = unit >> 8, n = unit & 255, b = bh >> 2, h = bh & 3, m0 = b * SEQ + n * 64;
        float bq[16], blast;
        GateIn gin; gates_load(a, m0, h, tid, gin);
        v4u qreg[2], kreg[2], vreg[4], rreg[4];
#pragma unroll
        for (int s2 = 0; s2 < 2; ++s2) { const int c = tid + 512 * s2; const bf16* rp = proj + (size_t)(m0 + (c >> 4)) * NIN + h * 128 + 8 * (c & 15); qreg[s2] = *(const v4u*)(rp + C_Q); kreg[s2] = *(const v4u*)(rp + C_K); }
#pragma unroll
        for (int s4 = 0; s4 < 4; ++s4) { const int c = tid + 512 * s4; const bf16* rp = proj + (size_t)(m0 + (c >> 5)) * NIN + h * 256 + 8 * (c & 31); vreg[s4] = *(const v4u*)(rp + C_V); rreg[s4] = *(const v4u*)(rp + C_R); }
        const bf16* Su = S + (size_t)unit * 32768;
        bf16x8 sf[4][2];
#pragma unroll
        for (int ks = 0; ks < 4; ++ks)
#pragma unroll
            for (int nt = 0; nt < 2; ++nt) sf[ks][nt] = *(const bf16x8*)(Su + (32 * wave + 16 * nt + r16) * 128 + 32 * ks + 8 * q4);
        gates_compute(gin, aL, tot, tid, bq, blast);
#pragma unroll
        for (int s2 = 0; s2 < 2; ++s2) { const int c = tid + 512 * s2; *(LAS v4u*)(Qs + (c >> 4) * 136 + 8 * (c & 15)) = qreg[s2]; *(LAS v4u*)(Ks + (c >> 4) * 136 + 8 * (c & 15)) = kreg[s2]; }
#pragma unroll
        for (int s4 = 0; s4 < 4; ++s4) { const int c = tid + 512 * s4; *(LAS v4u*)(Vs + (c >> 5) * 264 + 8 * (c & 31)) = vreg[s4]; *(LAS v4u*)(Rs + (c >> 5) * 264 + 8 * (c & 31)) = rreg[s4]; }
        __syncthreads();
#pragma unroll
        for (int ii = 0; ii < 16; ++ii) { const int i = 16 * ig + ii;
            const float qv = bf1(Qs[i * 136 + d]), kv = bf1(Ks[i * 136 + d]);
            Qs[i * 136 + d] = (bf16)(pk2(qv * 0.08838834764831845f * __expf(bq[ii]), 0.f) & 0xffffu);
            Ks[i * 136 + d] = (bf16)(pk2(kv * __expf(-bq[ii]), 0.f) & 0xffffu); }
        bf16x8 vf[2][2];
#pragma unroll
        for (int nt = 0; nt < 2; ++nt)
#pragma unroll
            for (int ks = 0; ks < 2; ++ks)
#pragma unroll
                for (int jj = 0; jj < 8; ++jj) vf[nt][ks][jj] = (short)Vs[(32 * ks + 8 * q4 + jj) * 264 + 32 * wave + 16 * nt + r16];
        __syncthreads();
#pragma unroll
        for (int tt = 0; tt < 2; ++tt) { const int t = 2 * wave + tt, it = t >> 2, jt = t & 3;
            f32x4 sc = (f32x4){0.f, 0.f, 0.f, 0.f};
            if (jt <= it) {
#pragma unroll
                for (int ks = 0; ks < 4; ++ks) { const bf16x8 af = *(const LAS bf16x8*)(Qs + (16 * it + r16) * 136 + 32 * ks + 8 * q4); const bf16x8 bf = *(const LAS bf16x8*)(Ks + (16 * jt + r16) * 136 + 32 * ks + 8 * q4);
                    sc = __builtin_amdgcn_mfma_f32_16x16x32_bf16(af, bf, sc, 0, 0, 0); } }
#pragma unroll
            for (int x = 0; x < 4; ++x) { const int i = 16 * it + 4 * q4 + x, j = 16 * jt + r16; Ps[i * 72 + j] = (bf16)(pk2(j <= i ? sc[x] : 0.f, 0.f) & 0xffffu); } }
        __syncthreads();
        f32x4 acc[4][2];
#pragma unroll
        for (int mt = 0; mt < 4; ++mt)
#pragma unroll
            for (int nt = 0; nt < 2; ++nt) acc[mt][nt] = (f32x4){0.f, 0.f, 0.f, 0.f};
#pragma unroll
        for (int ks = 0; ks < 2; ++ks)
#pragma unroll
            for (int mt = 0; mt < 4; ++mt) { const bf16x8 af = *(const LAS bf16x8*)(Ps + (16 * mt + r16) * 72 + 32 * ks + 8 * q4);
#pragma unroll
                for (int nt = 0; nt < 2; ++nt) acc[mt][nt] = __builtin_amdgcn_mfma_f32_16x16x32_bf16(af, vf[nt][ks], acc[mt][nt], 0, 0, 0); }
#pragma unroll
        for (int ks = 0; ks < 4; ++ks) {
#pragma unroll
            for (int mt = 0; mt < 4; ++mt) { const bf16x8 af = *(const LAS bf16x8*)(Qs + (16 * mt + r16) * 136 + 32 * ks + 8 * q4);
#pragma unroll
                for (int nt = 0; nt < 2; ++nt) acc[mt][nt] = __builtin_amdgcn_mfma_f32_16x16x32_bf16(af, sf[ks][nt], acc[mt][nt], 0, 0, 0); } }
#pragma unroll
        for (int mt = 0; mt < 4; ++mt)
#pragma unroll
            for (int x = 0; x < 4; ++x) { float ss = acc[mt][0][x] * acc[mt][0][x] + acc[mt][1][x] * acc[mt][1][x];
                ss += __shfl_xor(ss, 1); ss += __shfl_xor(ss, 2); ss += __shfl_xor(ss, 4); ss += __shfl_xor(ss, 8);
                if (r16 == 0) part[wave * 64 + 16 * mt + 4 * q4 + x] = ss; }
        __syncthreads();
        if (tid < 64) { float s = 0.f;
#pragma unroll
            for (int w = 0; w < 8; ++w) s += part[w * 64 + tid];
            rstdL[tid] = rsqrtf(s * (1.0f / 256.0f) + EPS); }
        __syncthreads();
#pragma unroll
        for (int nt = 0; nt < 2; ++nt) { const int e = 32 * wave + 16 * nt + r16; const float gw = a.in[I_GNW][e];
#pragma unroll
            for (int mt = 0; mt < 4; ++mt)
#pragma unroll
                for (int x = 0; x < 4; ++x) { const int i = 16 * mt + 4 * q4 + x; const float rr = bf1(Rs[i * 264 + e]);
                    const float y = acc[mt][nt][x] * rstdL[i] * gw * silu_f(rr);
                    Rs[i * 264 + e] = (bf16)(pk2(y, 0.f) & 0xffffu); } }
        __syncthreads();
#pragma unroll
        for (int s4 = 0; s4 < 4; ++s4) { const int c = tid + 512 * s4; *(v4u*)(Y + (size_t)(m0 + (c >> 5)) * D + 1024 + h * 256 + 8 * (c & 31)) = *(const LAS v4u*)(Rs + (c >> 5) * 264 + 8 * (c & 31)); }
        __syncthreads();
    }
}

__device__ __forceinline__ void phase_mid(const Args& a, int lane, int wave) {
    const float* mod = (const float*)(a.ws + WS_MOD); bf16* H = (bf16*)(a.ws + WS_H); const bf16* Yb = (const bf16*)(a.ws + WS_Y);
    const int NGW = gridDim.x * NWAVES;
    for (int rb = blockIdx.x * NWAVES + wave; rb < M / 16; rb += NGW) {
        const int m0 = rb * 16, b = m0 >> 14; const float* mb = mod + b * 12288;
        float G[4][8], A[4][8], B[4][8];
#pragma unroll
        for (int j = 0; j < 4; ++j)
#pragma unroll
            for (int e = 0; e < 8; ++e) { const int col = 512 * j + 8 * lane + e; G[j][e] = mb[4096 + col] * a.in[I_MIXPOST][col];
                A[j][e] = a.in[I_FPRE][col] * (1.0f + mb[8192 + col]); B[j][e] = mb[6144 + col]; }
        for (int r = 0; r < 16; ++r) {
            const size_t ro = (size_t)(m0 + r) * D + 8 * lane;
            float y[4][8]; float ss = 0.f;
#pragma unroll
            for (int j = 0; j < 4; ++j) { unpack8(*(const v4u*)(Yb + ro + 512 * j), y[j]);
#pragma unroll
                for (int e = 0; e < 8; ++e) ss += y[j][e] * y[j][e]; }
            const float rstd = rsqrtf(wave_sum(ss) * (1.0f / D) + EPS);
            float s2 = 0.f;
#pragma unroll
            for (int j = 0; j < 4; ++j) { const f32x4 xa = *(const f32x4*)(a.in[I_X] + ro + 512 * j), xb = *(const f32x4*)(a.in[I_X] + ro + 512 * j + 4);
#pragma unroll
                for (int e = 0; e < 8; ++e) { const float xv = (e < 4 ? xa[e & 3] : xb[e & 3]) + G[j][e] * (y[j][e] * rstd); y[j][e] = xv; s2 += xv * xv; }
                *(f32x4*)(a.out + ro + 512 * j) = (f32x4){y[j][0], y[j][1], y[j][2], y[j][3]}; *(f32x4*)(a.out + ro + 512 * j + 4) = (f32x4){y[j][4], y[j][5], y[j][6], y[j][7]}; }
            const float rstd2 = rsqrtf(wave_sum(s2) * (1.0f / D) + EPS);
#pragma unroll
            for (int j = 0; j < 4; ++j) { float o[8];
#pragma unroll
                for (int e = 0; e < 8; ++e) o[e] = y[j][e] * rstd2 * A[j][e] + B[j][e];
                *(v4u*)(H + ro + 512 * j) = pack8(o); }
        }
    }
}

__device__ __forceinline__ void phase_fixup(const Args& a, int tid) {
    const bf16* HALO = (const bf16*)(a.ws + WS_HALO); bf16* ACT = (bf16*)(a.ws + WS_ACT); const float* cw = a.in[I_FCONVW];
    const int total = gridDim.x * NT;
    for (int item = blockIdx.x * NT + tid; item < 512 * 2 * 704; item += total) {
        const int cg = item % 704, gl = item / 704, lr = gl & 1, G = gl >> 1, j0 = 8 * cg, uc = 256 * (j0 >> 7) + (j0 & 127);
        const bool first = (G & 255) == 0;
        const bf16* hc = HALO + ((size_t)G * 4 + lr) * NUP + uc;
        const bf16* h1 = lr == 0 ? HALO + ((size_t)(G - 1) * 4 + 3) * NUP + uc : HALO + ((size_t)G * 4 + 0) * NUP + uc;
        const bf16* h2 = lr == 0 ? HALO + ((size_t)(G - 1) * 4 + 2) * NUP + uc : HALO + ((size_t)(G - 1) * 4 + 3) * NUP + uc;
        float g0[8], v0[8], g1[8], v1[8], g2[8], v2[8], o[8];
        unpack8(*(const v4u*)hc, g0); unpack8(*(const v4u*)(hc + 128), v0);
#pragma unroll
        for (int e = 0; e < 8; ++e) { g1[e] = 0.f; v1[e] = 0.f; g2[e] = 0.f; v2[e] = 0.f; }
        if (!(first && lr == 0)) { unpack8(*(const v4u*)h1, g1); unpack8(*(const v4u*)(h1 + 128), v1); }
        if (!first) { unpack8(*(const v4u*)h2, g2); unpack8(*(const v4u*)(h2 + 128), v2); }
#pragma unroll
        for (int e = 0; e < 8; ++e) { const float gg = cw[j0 + e] * g2[e] + cw[NUP + j0 + e] * g1[e] + cw[2 * NUP + j0 + e] * g0[e];
            const float vv = cw[DFF + j0 + e] * v2[e] + cw[NUP + DFF + j0 + e] * v1[e] + cw[2 * NUP + DFF + j0 + e] * v0[e];
            o[e] = silu_f(gg) * vv; }
        *(v4u*)(ACT + (size_t)(G * 64 + lr) * DFF + j0) = pack8(o);
    }
}

__device__ __forceinline__ void phase_final(const Args& a, int lane, int wave) {
    const float* mod = (const float*)(a.ws + WS_MOD); const bf16* Yb = (const bf16*)(a.ws + WS_Y2);
    const int NGW = gridDim.x * NWAVES;
    for (int rb = blockIdx.x * NWAVES + wave; rb < M / 16; rb += NGW) {
        const int m0 = rb * 16, b = m0 >> 14; const float* mb = mod + b * 12288;
        float G[4][8];
#pragma unroll
        for (int j = 0; j < 4; ++j)
#pragma unroll
            for (int e = 0; e < 8; ++e) { const int col = 512 * j + 8 * lane + e; G[j][e] = mb[10240 + col] * a.in[I_FPOST][col]; }
        for (int r = 0; r < 16; ++r) {
            const size_t ro = (size_t)(m0 + r) * D + 8 * lane;
            float y[4][8]; float ss = 0.f;
#pragma unroll
            for (int j = 0; j < 4; ++j) { unpack8(*(const v4u*)(Yb + ro + 512 * j), y[j]);
#pragma unroll
                for (int e = 0; e < 8; ++e) ss += y[j][e] * y[j][e]; }
            const float rstd = rsqrtf(wave_sum(ss) * (1.0f / D) + EPS);
#pragma unroll
            for (int j = 0; j < 4; ++j) { f32x4 xa = *(const f32x4*)(a.out + ro + 512 * j), xb = *(const f32x4*)(a.out + ro + 512 * j + 4);
#pragma unroll
                for (int e = 0; e < 4; ++e) { xa[e] += G[j][e] * (y[j][e] * rstd); xb[e] += G[j][e + 4] * (y[j][e + 4] * rstd); }
                *(f32x4*)(a.out + ro + 512 * j) = xa; *(f32x4*)(a.out + ro + 512 * j + 4) = xb; }
        }
    }
}

constexpr int N_PHASES = 12;
#ifndef REP_GEMM
#define REP_GEMM 1
#endif
#ifndef REP_A
#define REP_A 1
#endif
#ifndef REP_B
#define REP_B 1
#endif
#ifndef REP_C
#define REP_C 1
#endif
__global__ void __launch_bounds__(NT, 2) fwd_kernel(Args args) {
    extern __shared__ __attribute__((aligned(16))) unsigned char lds_raw[];
    LAS unsigned char* lds = (LAS unsigned char*)lds_raw;
    const int tid = threadIdx.x, lane = tid & 63, wave = __builtin_amdgcn_readfirstlane(tid >> 6);
    const int lo = args.ph_lo, hi = args.ph_hi; unsigned char* ws = args.ws;
#define IN(k) (lo <= (k) && (k) < hi)
#define SEAM(k) do { if (IN(k) && IN((k) + 1)) { asm volatile("s_waitcnt vmcnt(0) lgkmcnt(0)" ::: "memory"); cg::this_grid().sync(); } } while (0)
    if (IN(0)) { for (int rep = 0; rep < REP_A; ++rep) { phase_prologue(args, lds, tid, lane, wave); __syncthreads(); } } SEAM(0);
    if (IN(1)) { for (int rep = 0; rep < REP_A; ++rep) { phase_h1(args, lane, wave); __syncthreads(); } } SEAM(1);
    if (IN(2)) { pg8::Gemm g{(const bf16*)(ws + WS_H), (const bf16*)(ws + WS_WIN), M, NIN, D}; pg8::StaticOrder S; S.init(M, NIN, gridDim.x, blockIdx.x);
        pg8::EpiB16 E{(bf16*)(ws + WS_PROJ), NIN};
        _Pragma("unroll") for (int rep = 0; rep < REP_GEMM; ++rep) { pg8::gemm_phase<pg8::EpiB16, pg8::StaticOrder, true, true>(lds, g, S, E); __syncthreads(); } } SEAM(2);
    if (IN(3)) { for (int rep = 0; rep < REP_B; ++rep) { phase_g1(args, lds, tid, lane, wave); __syncthreads(); } } SEAM(3);
    if (IN(4)) { phase_g2(args, tid); } SEAM(4);
    if (IN(5)) { for (int rep = 0; rep < REP_B; ++rep) { phase_g3(args, lds, tid, lane, wave); __syncthreads(); } } SEAM(5);
    if (IN(6)) { pg8::Gemm g{(const bf16*)(ws + WS_H), (const bf16*)(ws + WS_WOUT), M, D, D}; pg8::StaticOrder S; S.init(M, D, gridDim.x, blockIdx.x);
        pg8::EpiB16 E{(bf16*)(ws + WS_Y), D};
        _Pragma("unroll") for (int rep = 0; rep < REP_GEMM; ++rep) { pg8::gemm_phase<pg8::EpiB16, pg8::StaticOrder, true, true>(lds, g, S, E); __syncthreads(); } } SEAM(6);
    if (IN(7)) { for (int rep = 0; rep < REP_A; ++rep) { phase_mid(args, lane, wave); __syncthreads(); } } SEAM(7);
    if (IN(8)) { pg8::Gemm g{(const bf16*)(ws + WS_H), (const bf16*)(ws + WS_WUP), M, NUP, D}; pg8::StaticOrder S; S.init(M, NUP, gridDim.x, blockIdx.x);
        pg8::EpiConvGate E{(bf16*)(ws + WS_ACT), (bf16*)(ws + WS_HALO), args.in[I_FCONVW]};
        _Pragma("unroll") for (int rep = 0; rep < REP_GEMM; ++rep) { pg8::gemm_phase<pg8::EpiConvGate, pg8::StaticOrder, true, true>(lds, g, S, E); __syncthreads(); } } SEAM(8);
    if (IN(9)) { phase_fixup(args, tid); } SEAM(9);
    if (IN(10)) { pg8::Gemm g{(const bf16*)(ws + WS_ACT), (const bf16*)(ws + WS_WDN), M, D, DFF}; pg8::StaticOrder S; S.init(M, D, gridDim.x, blockIdx.x);
        pg8::EpiB16 E{(bf16*)(ws + WS_Y2), D};
        _Pragma("unroll") for (int rep = 0; rep < REP_GEMM; ++rep) { pg8::gemm_phase<pg8::EpiB16, pg8::StaticOrder, true, true>(lds, g, S, E); __syncthreads(); } } SEAM(10);
    if (IN(11)) { phase_final(args, lane, wave); }
#undef IN
#undef SEAM
}

#ifndef N_LAUNCH_MODE
#define N_LAUNCH_MODE 1
#endif
extern "C" void kernel_launch(void* const* d_in, const int* in_sizes, int n_in, void* d_out, int out_size, void* d_ws, size_t ws_size, hipStream_t stream) {
    static int grid = 0;
    if (grid == 0) {
        if (n_in != 17 || out_size != M * D || ws_size < WS_END) { fprintf(stderr, "kernel_launch: unexpected shapes (n_in %d out %d ws %zu)\n", n_in, out_size, ws_size); grid = -1; return; }
        int dev = 0, cus = 0, per_cu = 0;
        hipGetDevice(&dev); hipDeviceGetAttribute(&cus, hipDeviceAttributeMultiprocessorCount, dev);
        hipFuncSetAttribute((const void*)fwd_kernel, hipFuncAttributeMaxDynamicSharedMemorySize, LDS_BYTES);
        hipOccupancyMaxActiveBlocksPerMultiprocessor(&per_cu, (const void*)fwd_kernel, NT, LDS_BYTES);
        if (per_cu < 1) { fprintf(stderr, "kernel_launch: occupancy query says %d blocks per CU\n", per_cu); per_cu = 1; }
        (void)hipGetLastError();
        grid = cus * per_cu;
        fprintf(stderr, "kernel_launch: grid %d (cus %d x %d)\n", grid, cus, per_cu);
    }
    if (grid < 0) return;
    Args a{};
    for (int i = 0; i < 17; ++i) a.in[i] = (const float*)d_in[i];
    a.out = (float*)d_out; a.ws = (unsigned char*)d_ws;
#if N_LAUNCH_MODE == 1
    a.ph_lo = 0; a.ph_hi = N_PHASES;
    void* kargs[] = {&a};
    hipError_t e = hipLaunchCooperativeKernel((const void*)fwd_kernel, dim3(grid), dim3(NT), kargs, LDS_BYTES, stream);
    if (e != hipSuccess) fprintf(stderr, "cooperative launch failed: %s (grid %d)\n", hipGetErrorString(e), grid);
#else
    for (int p = 0; p < N_PHASES; ++p) { a.ph_lo = p; a.ph_hi = p + 1; hipLaunchKernelGGL(fwd_kernel, dim3(grid), dim3(NT), LDS_BYTES, stream, a); }
#endif
}
```

```cpp
#include <hip/hip_runtime.h>
#include <hip/hip_cooperative_groups.h>
#include <cstdio>
#include <cstdint>
namespace cg = cooperative_groups;
namespace pg8 {
#define PG8_LAS __attribute__((address_space(3)))
typedef unsigned short bf16_t;
typedef short bf16x8 __attribute__((ext_vector_type(8)));
typedef float f32x4 __attribute__((ext_vector_type(4)));
typedef unsigned u32x4 __attribute__((ext_vector_type(4)));
typedef unsigned u32x2 __attribute__((ext_vector_type(2)));
typedef float f32x2 __attribute__((ext_vector_type(2)));
constexpr int BM = 256, BK = 64, HALF = 128, HTB = HALF * BK * 2  , STAGE_BYTES = 8 * HTB, NXCD = 8, WGM = 8;

__host__ __device__ __forceinline__ int lds_byte(int r, int c) { const int st = (r >> 4) * 2 + (c >> 5), rr = r & 15, cc = c & 31, ob = rr * 64 + cc * 2; return st * 1024 + (ob ^ (((ob >> 9) & 1) << 5)); }
__host__ __device__ __forceinline__ void stage_rc(int b, int& R, int& C) { const int st = b / 1024, sb = b % 1024, swz = sb ^ (((sb >> 9) & 1) << 5); R = (st >> 1) * 16 + swz / 64; C = (st & 1) * 32 + (swz % 64) / 2; }
__host__ __device__ __forceinline__ int perm32(int rho) { const int n = rho >> 4, i = rho & 15; return 8 * (i >> 2) + 4 * n + (i & 3); }

struct Unit { int pm, pn; };
struct Gemm { const bf16_t* A; const bf16_t* Bt; int M, N, K; };

struct StaticOrder {
    int nM, nN, nwg, G, c;
    __host__ __device__ void init(int M, int N, int G_, int c_) { nM = M / BM; nN = N / BM; nwg = nM * nN; G = G_; c = c_; }
    __host__ __device__ bool next(int i, Unit& u) const {
        const long L = (long)i * G + c; if (L >= nwg) return false;
        int wgid = (int)L; { const int q = nwg / NXCD, r = nwg % NXCD, xcd = wgid % NXCD, off = wgid / NXCD; wgid = (xcd < r ? xcd * (q + 1) : r * (q + 1) + (xcd - r) * q) + off; }
        const int nig = WGM * nN, gid = wgid / nig, fm = gid * WGM, gsz = (nM - fm) < WGM ? (nM - fm) : WGM;
        u.pm = fm + ((wgid % nig) % gsz); u.pn = (wgid % nig) / gsz; return true;
    }
    __device__ __forceinline__ void a_ready(const Unit&) const {}
    __device__ __forceinline__ void done(const Unit&) const {}
};

__device__ __forceinline__ unsigned cvt_pk_bf16(float lo, float hi) { unsigned r; asm volatile("v_cvt_pk_bf16_f32 %0, %1, %2" : "=v"(r) : "v"(lo), "v"(hi)); return r; }
typedef float cvt_f32x2_t __attribute__((ext_vector_type(2))); typedef __bf16 cvt_bf16x2_t __attribute__((ext_vector_type(2)));
__device__ __forceinline__ unsigned cvt_pk_bf16_safe(float lo, float hi) { cvt_f32x2_t v = {lo, hi}; cvt_bf16x2_t b = __builtin_convertvector(v, cvt_bf16x2_t); return __builtin_bit_cast(unsigned, b); }
#define PG8_MFMA_SETTLE() asm volatile("s_nop 7\n\ts_nop 7\n\ts_nop 7" ::: "memory")
struct EpiB16 {
    static constexpr bool PERM = true, AFTER_DRAIN = false;
    bf16_t* O; int ldc;
    __device__ __forceinline__ void operator()(const f32x4 (&acc)[2][2][4][2], const Unit& u, int wr, int wc, int fr, int fq) const {
        PG8_MFMA_SETTLE();
        const int row0 = u.pm * BM + wr * 64 + fr, col0 = u.pn * BM + wc * 32 + 8 * fq;
#pragma unroll
        for (int ai = 0; ai < 2; ++ai)
#pragma unroll
            for (int m = 0; m < 4; ++m) { bf16_t* rowp = O + (size_t)(row0 + ai * HALF + m * 16) * ldc + col0;
#pragma unroll
                for (int bj = 0; bj < 2; ++bj) { const f32x4 v0 = acc[ai][bj][m][0], v1 = acc[ai][bj][m][1];
                    u32x4 w; w.x = cvt_pk_bf16(v0[0], v0[1]); w.y = cvt_pk_bf16(v0[2], v0[3]); w.z = cvt_pk_bf16(v1[0], v1[1]); w.w = cvt_pk_bf16(v1[2], v1[3]);
                    *(u32x4*)(rowp + bj * HALF) = w; } }
    }
};
struct EpiProj {
    static constexpr bool PERM = true, AFTER_DRAIN = false;
    bf16_t* O; float* alr;
    __device__ __forceinline__ void operator()(const f32x4 (&acc)[2][2][4][2], const Unit& u, int wr, int wc, int fr, int fq) const {
        PG8_MFMA_SETTLE();
        const int row0 = u.pm * BM + wr * 64 + fr;
        if (u.pn < 24) {
            const int col0 = u.pn * BM + wc * 32 + 8 * fq;
#pragma unroll
            for (int ai = 0; ai < 2; ++ai)
#pragma unroll
                for (int m = 0; m < 4; ++m) { bf16_t* rowp = O + (size_t)(row0 + ai * HALF + m * 16) * 6144 + col0;
#pragma unroll
                    for (int bj = 0; bj < 2; ++bj) { const f32x4 v0 = acc[ai][bj][m][0], v1 = acc[ai][bj][m][1];
                        u32x4 w; w.x = cvt_pk_bf16(v0[0], v0[1]); w.y = cvt_pk_bf16(v0[2], v0[3]); w.z = cvt_pk_bf16(v1[0], v1[1]); w.w = cvt_pk_bf16(v1[2], v1[3]);
                        *(u32x4*)(rowp + bj * HALF) = w; } }
        } else if (wc == 0 && fq < 2) {
#pragma unroll
            for (int ai = 0; ai < 2; ++ai)
#pragma unroll
                for (int m = 0; m < 4; ++m) { float* rp = alr + (size_t)(row0 + ai * HALF + m * 16) * 16 + 8 * fq;
                    *(f32x4*)rp = acc[ai][0][m][0]; *(f32x4*)(rp + 4) = acc[ai][0][m][1]; }
        }
    }
};

template <int CTRL> __device__ __forceinline__ float dpp_ror(float v) { return __builtin_bit_cast(float, __builtin_amdgcn_update_dpp(0, __builtin_bit_cast(int, v), CTRL, 0xf, 0xf, false)); }
struct EpiConvGate {
    static constexpr bool PERM = true, AFTER_DRAIN = false;
    bf16_t* ACT; bf16_t* HALO; const float* cw;
    __device__ __forceinline__ void operator()(const f32x4 (&acc)[2][2][4][2], const Unit& u, int wr, int wc, int fr, int fq) const {
        PG8_MFMA_SETTLE();
        constexpr int NUPc = 11264, DFFc = 5632;
        const int j0 = u.pn * 128 + wc * 32 + 8 * fq;
        const int ucol = u.pn * BM + wc * 32 + 8 * fq;
        f32x4 wg[2][3], wv[2][3];
#pragma unroll
        for (int k = 0; k < 3; ++k) { wg[0][k] = *(const f32x4*)(cw + k * NUPc + j0); wv[0][k] = *(const f32x4*)(cw + k * NUPc + DFFc + j0); }
#pragma unroll
        for (int ai = 0; ai < 2; ++ai) {
            const int grp = u.pm * 4 + ai * 2 + wr;
            if (fr < 2 || fr >= 14) { const int rr = fr < 2 ? fr : fr - 12; bf16_t* hp = HALO + ((size_t)grp * 4 + rr) * NUPc + ucol;
#pragma unroll
                for (int bj = 0; bj < 2; ++bj) { const f32x4 v0 = fr < 2 ? acc[ai][bj][0][0] : acc[ai][bj][3][0], v1 = fr < 2 ? acc[ai][bj][0][1] : acc[ai][bj][3][1];
                    u32x4 w; w.x = cvt_pk_bf16(v0[0], v0[1]); w.y = cvt_pk_bf16(v0[2], v0[3]); w.z = cvt_pk_bf16(v1[0], v1[1]); w.w = cvt_pk_bf16(v1[2], v1[3]);
                    *(u32x4*)(hp + bj * HALF) = w; } }
        }
#pragma unroll
        for (int n = 0; n < 2; ++n) {
            if (n == 1) {
                asm volatile("" ::: "memory"); __builtin_amdgcn_sched_barrier(0);
#pragma unroll
                for (int k = 0; k < 3; ++k) { wg[1][k] = *(const f32x4*)(cw + k * NUPc + j0 + 4); wv[1][k] = *(const f32x4*)(cw + k * NUPc + DFFc + j0 + 4); } }
#pragma unroll
            for (int ai = 0; ai < 2; ++ai) {
                __builtin_amdgcn_sched_barrier(0);
                const int jc = j0 + 4 * n;
                f32x2 o[4][2];
#pragma unroll
                for (int xp = 0; xp < 2; ++xp) {
                    const f32x2 a0 = (f32x2){wg[n][0][2 * xp], wg[n][0][2 * xp + 1]}, a1 = (f32x2){wg[n][1][2 * xp], wg[n][1][2 * xp + 1]}, a2 = (f32x2){wg[n][2][2 * xp], wg[n][2][2 * xp + 1]};
                    const f32x2 b0 = (f32x2){wv[n][0][2 * xp], wv[n][0][2 * xp + 1]}, b1 = (f32x2){wv[n][1][2 * xp], wv[n][1][2 * xp + 1]}, b2 = (f32x2){wv[n][2][2 * xp], wv[n][2][2 * xp + 1]};
                    f32x2 g1p = (f32x2){0.f, 0.f}, g2p = g1p, v1p = g1p, v2p = g1p;
#pragma unroll
                    for (int m = 0; m < 4; ++m) {
                        const f32x2 g = (f32x2){acc[ai][0][m][n][2 * xp], acc[ai][0][m][n][2 * xp + 1]}, v = (f32x2){acc[ai][1][m][n][2 * xp], acc[ai][1][m][n][2 * xp + 1]};
                        f32x2 g1, g2, v1, v2, ga, gb, va, vb;
#pragma unroll
                        for (int c = 0; c < 2; ++c) { g1[c] = dpp_ror<0x121>(g[c]); g2[c] = dpp_ror<0x122>(g[c]); v1[c] = dpp_ror<0x121>(v[c]); v2[c] = dpp_ror<0x122>(v[c]);
                            ga[c] = fr == 0 ? g1p[c] : g1[c]; gb[c] = fr < 2 ? g2p[c] : g2[c]; va[c] = fr == 0 ? v1p[c] : v1[c]; vb[c] = fr < 2 ? v2p[c] : v2[c]; }
                        const f32x2 G = a0 * gb + a1 * ga + a2 * g, V = b0 * vb + b1 * va + b2 * v;
                        const f32x2 t = G * (-1.4426950408889634f);
                        f32x2 e; e.x = __builtin_amdgcn_exp2f(t.x); e.y = __builtin_amdgcn_exp2f(t.y);
                        const f32x2 dn = e + 1.0f;
                        f32x2 rc; rc.x = __builtin_amdgcn_rcpf(dn.x); rc.y = __builtin_amdgcn_rcpf(dn.y);
                        o[m][xp] = (G * rc) * V;
                        g1p = g1; g2p = g2; v1p = v1; v2p = v2;
                    }
                }
#pragma unroll
                for (int m = 0; m < 4; ++m) { const int row = u.pm * BM + ai * HALF + wr * 64 + m * 16 + fr;
                    u32x2 w; w.x = cvt_pk_bf16(o[m][0].x, o[m][0].y); w.y = cvt_pk_bf16(o[m][1].x, o[m][1].y);
                    if (m > 0 || fr >= 2) *(u32x2*)(ACT + (size_t)row * DFFc + jc) = w; }
            }
        }
    }
};

template <class Epi, class Sched, bool ALIGN_EPI = false, bool SP2 = false>
__device__ __forceinline__ void gemm_phase(PG8_LAS unsigned char* lds, const Gemm g, const Sched& S, const Epi& E) {
    const int tid = threadIdx.x, wid = __builtin_amdgcn_readfirstlane(tid >> 6), lane = tid & 63, wr = wid >> 2, wc = wid & 3, fr = lane & 15, fq = lane >> 4;
    const int K = g.K, nt = K / BK;
    unsigned voffA[2], voffB[2];
#pragma unroll
    for (int i = 0; i < 2; ++i) { int R, C; stage_rc(tid * 16 + i * 8192, R, C); const int Rb = Epi::PERM ? ((R & ~31) + perm32(R & 31)) : R;
        voffA[i] = (unsigned)(R * K + C) * 2u; voffB[i] = (unsigned)(Rb * K + C) * 2u; }
    const size_t kstep = (size_t)(BK * 2);
    const size_t hstep = (size_t)HALF * K * 2;
    const size_t tstep = 2 * hstep;
    const unsigned ldsw = (unsigned)wid * 1024u;
    const int aoff = lds_byte(wr * 64 + fr, fq * 8), boff = lds_byte(wc * 32 + fr, fq * 8);
#define PG8_SA(b, h) (((b) * 2 + (h)) * HTB)
#define PG8_SB(b, h) ((4 + (b) * 2 + (h)) * HTB)
#define PG8_STAGE(bufoff, gbase, voff) do { _Pragma("unroll") for (int _i = 0; _i < 2; ++_i) \
        __builtin_amdgcn_global_load_lds((const unsigned*)((const char*)(gbase) + (voff)[_i]), (PG8_LAS unsigned*)(lds + (bufoff) + ldsw + _i * 8192), 16, 0, 0); } while (0)
#define PG8_LDA(dst, b, h) do { _Pragma("unroll") for (int m = 0; m < 4; ++m) _Pragma("unroll") for (int k = 0; k < 2; ++k) dst[m][k] = *(const PG8_LAS bf16x8*)(lds + PG8_SA(b, h) + aoff + m * 2048 + k * 1024); } while (0)
#define PG8_LDB(dst, b, h) do { _Pragma("unroll") for (int n = 0; n < 2; ++n) _Pragma("unroll") for (int k = 0; k < 2; ++k) dst[n][k] = *(const PG8_LAS bf16x8*)(lds + PG8_SB(b, h) + boff + n * 2048 + k * 1024); } while (0)
#define PG8_MMA(ai, bj, At, Bt) do { __builtin_amdgcn_s_setprio(1); _Pragma("unroll") for (int m = 0; m < 4; ++m) _Pragma("unroll") for (int n = 0; n < 2; ++n) _Pragma("unroll") for (int k = 0; k < 2; ++k) \
        acc[ai][bj][m][n] = __builtin_amdgcn_mfma_f32_16x16x32_bf16(Bt[n][k], At[m][k], acc[ai][bj][m][n], 0, 0, 0); __builtin_amdgcn_s_setprio(0); } while (0)
#define PG8_WAIT_V(n) asm volatile("s_waitcnt vmcnt(" #n ")" ::: "memory")
#define PG8_WAIT_L(n) asm volatile("s_waitcnt lgkmcnt(" #n ")" ::: "memory")
#define PG8_BAR __builtin_amdgcn_s_barrier()
#define PG8_SCHED __builtin_amdgcn_sched_barrier(0)
    Unit cur, nxt; int ui = 0;
    if (!S.next(0, cur)) return;
    f32x4 acc[2][2][4][2];
#pragma unroll
    for (int a = 0; a < 2; ++a)
#pragma unroll
        for (int b = 0; b < 2; ++b)
#pragma unroll
            for (int m = 0; m < 4; ++m)
#pragma unroll
                for (int n = 0; n < 2; ++n) acc[a][b][m][n] = (f32x4){0.f, 0.f, 0.f, 0.f};
    bf16x8 At[4][2], B0[2][2], B1[2][2];
    const char* cA = (const char*)g.A + (size_t)cur.pm * tstep; const char* cB = (const char*)g.Bt + (size_t)cur.pn * tstep;
    S.a_ready(cur);
    if constexpr (SP2) {
        PG8_STAGE(PG8_SB(0, 0), cB, voffB); PG8_STAGE(PG8_SB(0, 1), cB + hstep, voffB); PG8_STAGE(PG8_SA(0, 0), cA, voffA); PG8_STAGE(PG8_SA(0, 1), cA + hstep, voffA);
        if (wr == 1) PG8_BAR;
        PG8_WAIT_V(2); PG8_BAR;
        PG8_STAGE(PG8_SB(1, 0), cB + kstep, voffB); PG8_STAGE(PG8_SA(1, 0), cA + kstep, voffA); PG8_STAGE(PG8_SB(1, 1), cB + hstep + kstep, voffB);
        PG8_WAIT_V(6); PG8_BAR;
    } else {
        PG8_STAGE(PG8_SB(0, 0), cB, voffB); PG8_STAGE(PG8_SA(0, 0), cA, voffA); PG8_STAGE(PG8_SB(0, 1), cB + hstep, voffB); PG8_STAGE(PG8_SA(0, 1), cA + hstep, voffA);
        if (wr == 1) PG8_BAR;
        PG8_WAIT_V(4); PG8_BAR;
        PG8_STAGE(PG8_SB(1, 0), cB + kstep, voffB); PG8_STAGE(PG8_SA(1, 0), cA + kstep, voffA); PG8_STAGE(PG8_SB(1, 1), cB + hstep + kstep, voffB);
        PG8_WAIT_V(6); PG8_BAR;
    }
    for (;;) {
        const bool has_next = S.next(ui + 1, nxt);
        const char* nA = has_next ? (const char*)g.A + (size_t)nxt.pm * tstep : cA; const char* nB = has_next ? (const char*)g.Bt + (size_t)nxt.pn * tstep : cB;
        for (int t = 0; t < nt; t += 2) {
            const bool last = (t == nt - 2);
            const char* a1 = cA + (size_t)(t + 1) * kstep;
            const char* a2 = last ? nA : cA + (size_t)(t + 2) * kstep; const char* b2 = last ? nB : cB + (size_t)(t + 2) * kstep;
            const char* a3 = a2 + kstep; const char* b3 = b2 + kstep;
            if (last && has_next) S.a_ready(nxt);
            if constexpr (SP2) {
            PG8_LDB(B0, 0, 0); PG8_LDB(B1, 0, 1); PG8_SCHED; PG8_LDA(At, 0, 0); PG8_STAGE(PG8_SA(1, 1), a1 + hstep, voffA);
            PG8_WAIT_V(8); PG8_WAIT_L(0); PG8_BAR; PG8_MMA(0, 0, At, B0); PG8_MMA(0, 1, At, B1); PG8_BAR; PG8_SCHED;
            PG8_LDA(At, 0, 1); PG8_STAGE(PG8_SB(0, 0), b2, voffB); PG8_STAGE(PG8_SB(0, 1), b2 + hstep, voffB); PG8_STAGE(PG8_SA(0, 0), a2, voffA);
            PG8_WAIT_V(8); PG8_WAIT_L(0); PG8_BAR; PG8_MMA(1, 0, At, B0); PG8_MMA(1, 1, At, B1); PG8_BAR; PG8_SCHED;
            PG8_LDB(B0, 1, 0); PG8_LDB(B1, 1, 1); PG8_SCHED; PG8_LDA(At, 1, 0); PG8_STAGE(PG8_SA(0, 1), a2 + hstep, voffA);
            PG8_WAIT_V(8); PG8_WAIT_L(0); PG8_BAR; PG8_MMA(0, 0, At, B0); PG8_MMA(0, 1, At, B1); PG8_BAR; PG8_SCHED;
            PG8_LDA(At, 1, 1); PG8_STAGE(PG8_SB(1, 0), b3, voffB); PG8_STAGE(PG8_SB(1, 1), b3 + hstep, voffB); PG8_STAGE(PG8_SA(1, 0), a3, voffA);
            PG8_WAIT_V(8); PG8_WAIT_L(0); PG8_BAR; PG8_MMA(1, 0, At, B0); PG8_MMA(1, 1, At, B1); PG8_BAR; PG8_SCHED;
            } else {
            PG8_LDB(B0, 0, 0); PG8_SCHED; PG8_LDA(At, 0, 0); PG8_STAGE(PG8_SA(1, 1), a1 + hstep, voffA);
            PG8_WAIT_L(8); PG8_BAR; PG8_WAIT_L(0); PG8_MMA(0, 0, At, B0); PG8_BAR; PG8_SCHED;
            PG8_LDB(B1, 0, 1); PG8_STAGE(PG8_SB(0, 0), b2, voffB);
            PG8_BAR; PG8_WAIT_L(0); PG8_MMA(0, 1, At, B1); PG8_BAR;
            PG8_LDA(At, 0, 1); PG8_STAGE(PG8_SA(0, 0), a2, voffA);
            PG8_BAR; PG8_WAIT_L(0); PG8_MMA(1, 0, At, B0); PG8_BAR; PG8_SCHED;
            PG8_STAGE(PG8_SB(0, 1), b2 + hstep, voffB);
            PG8_WAIT_V(6); PG8_BAR; PG8_MMA(1, 1, At, B1); PG8_BAR;
            PG8_LDB(B0, 1, 0); PG8_SCHED; PG8_LDA(At, 1, 0); PG8_STAGE(PG8_SA(0, 1), a2 + hstep, voffA);
            PG8_WAIT_L(8); PG8_BAR; PG8_WAIT_L(0); PG8_MMA(0, 0, At, B0); PG8_BAR; PG8_SCHED;
            PG8_LDB(B1, 1, 1); PG8_STAGE(PG8_SB(1, 0), b3, voffB);
            PG8_BAR; PG8_WAIT_L(0); PG8_MMA(0, 1, At, B1); PG8_BAR;
            PG8_LDA(At, 1, 1); PG8_STAGE(PG8_SA(1, 0), a3, voffA);
            PG8_BAR; PG8_WAIT_L(0); PG8_MMA(1, 0, At, B0); PG8_BAR; PG8_SCHED;
            PG8_STAGE(PG8_SB(1, 1), b3 + hstep, voffB);
            PG8_WAIT_V(6); PG8_BAR; PG8_MMA(1, 1, At, B1); PG8_BAR;
            }
        }
        if constexpr (ALIGN_EPI) { if (wr == 0) PG8_BAR; }
        if constexpr (!Epi::AFTER_DRAIN) { E(acc, cur, wr, wc, fr, fq); S.done(cur); }
        if (!has_next) break;
#pragma unroll
        for (int a = 0; a < 2; ++a)
#pragma unroll
            for (int b = 0; b < 2; ++b)
#pragma unroll
                for (int m = 0; m < 4; ++m)
#pragma unroll
                    for (int n = 0; n < 2; ++n) acc[a][b][m][n] = (f32x4){0.f, 0.f, 0.f, 0.f};
        cur = nxt; cA = nA; cB = nB; ++ui;
        if constexpr (ALIGN_EPI) { if (wr == 1) PG8_BAR; }
    }
    PG8_WAIT_V(0);
    if constexpr (!ALIGN_EPI) { if (wr == 0) PG8_BAR; }
    PG8_BAR;
    if constexpr (Epi::AFTER_DRAIN) { E.fused(acc, cur, wr, wc, fr, fq, lds, wid, lane); S.done(cur); }
#undef PG8_SA
#undef PG8_SB
#undef PG8_STAGE
#undef PG8_LDA
#undef PG8_LDB
#undef PG8_MMA
#undef PG8_WAIT_V
#undef PG8_WAIT_L
#undef PG8_BAR
#undef PG8_SCHED
}
}

constexpr int NWAVES = 8, NT = 512;
constexpr int SEQ = 16384, M = 32768, D = 2048, NIN = 6144, NINP = 6400, NIN_SRC = 6160, DFF = 5632, NUP = 11264, MH = 16384;
constexpr int C_CB = 0, C_CC = 1024, C_CX = 2048, C_Q = 3072, C_K = 3584, C_V = 4096, C_R = 5120;
constexpr float EPS = 1e-6f;
constexpr size_t MiB = 1u << 20;
constexpr size_t WS_MOD = 1 * MiB;
constexpr size_t WS_WIN = 2 * MiB, WS_WOUT = 27 * MiB, WS_WUP = 35 * MiB, WS_WDN = 79 * MiB;
constexpr size_t WS_H = 104 * MiB;
constexpr size_t WS_PROJ = 232 * MiB;
constexpr size_t WS_ALR = 616 * MiB;
constexpr size_t WS_S = 618 * MiB;
constexpr size_t WS_DEC = 746 * MiB;
constexpr size_t WS_Y = 748 * MiB;
constexpr size_t WS_HALO = 232 * MiB;
constexpr size_t WS_ACT = 584 * MiB;
constexpr size_t WS_Y2 = 232 * MiB;
constexpr size_t WS_END = 936 * MiB;
constexpr int LDS_BYTES = 147456;

#define GAS __attribute__((address_space(1)))
#define LAS __attribute__((address_space(3)))
typedef unsigned short bf16;
typedef unsigned v4u __attribute__((ext_vector_type(4)));
typedef unsigned v2u __attribute__((ext_vector_type(2)));
typedef float f32x4 __attribute__((ext_vector_type(4)));
typedef float f32x2 __attribute__((ext_vector_type(2)));
typedef short bf16x8 __attribute__((ext_vector_type(8)));
#define LDS_WAIT() asm volatile("s_waitcnt lgkmcnt(0)" ::: "memory")

__device__ __forceinline__ unsigned pk2(float lo, float hi) { return pg8::cvt_pk_bf16_safe(lo, hi); }
__device__ __forceinline__ float bflo(unsigned w) { return __uint_as_float(w << 16); }
__device__ __forceinline__ float bfhi(unsigned w) { return __uint_as_float(w & 0xffff0000u); }
__device__ __forceinline__ float bf1(bf16 b) { return __uint_as_float(((unsigned)b) << 16); }
__device__ __forceinline__ float silu_f(float v) { return v / (1.0f + __expf(-v)); }
__device__ __forceinline__ float wave_sum(float v) {
#pragma unroll
    for (int o = 1; o < 64; o <<= 1) v += __shfl_xor(v, o);
    return v;
}
__device__ __forceinline__ void unpack8(const v4u w, float (&f)[8]) {
    f[0] = bflo(w.x); f[1] = bfhi(w.x); f[2] = bflo(w.y); f[3] = bfhi(w.y); f[4] = bflo(w.z); f[5] = bfhi(w.z); f[6] = bflo(w.w); f[7] = bfhi(w.w);
}
__device__ __forceinline__ v4u pack8(const float (&f)[8]) { v4u w; w.x = pk2(f[0], f[1]); w.y = pk2(f[2], f[3]); w.z = pk2(f[4], f[5]); w.w = pk2(f[6], f[7]); return w; }

struct Args { const float* in[17]; float* out; unsigned char* ws; int ph_lo, ph_hi; };
enum { I_X = 0, I_C, I_WMOD, I_BMOD, I_MIXPRE, I_MIXPOST, I_WIN, I_CONVW, I_GW2, I_GB, I_GNW, I_WOUT, I_FPRE, I_FPOST, I_WUP, I_FCONVW, I_WDN };

__device__ __forceinline__ void transpose_item(const float* W, int K, int N, int k0, int n0, int ncols, bf16* WT, int drow0, LAS float* scr, int lane) {
    const int cl = lane & 31; const bool cv = cl < ncols;
#pragma unroll 8
    for (int i = 0; i < 32; ++i) { const int kk = 2 * i + (lane >> 5); scr[kk * 33 + cl] = cv ? W[(size_t)(k0 + kk) * N + n0 + cl] : 0.f; }
    LDS_WAIT(); asm volatile("" ::: "memory");
    const int c = lane & 7;
#pragma unroll
    for (int j = 0; j < 4; ++j) { const int n = (lane >> 3) + 8 * j; const LAS float* s = scr + (8 * c) * 33 + n;
        v4u o; o.x = pk2(s[0 * 33], s[1 * 33]); o.y = pk2(s[2 * 33], s[3 * 33]); o.z = pk2(s[4 * 33], s[5 * 33]); o.w = pk2(s[6 * 33], s[7 * 33]);
        if (n < ncols) *(v4u*)(WT + (size_t)(drow0 + n) * K + k0 + 8 * c) = o; }
    LDS_WAIT(); asm volatile("" ::: "memory");
}

__device__ __forceinline__ void phase_prologue(const Args& a, LAS unsigned char* lds, int tid, int lane, int wave) {
    unsigned char* ws = a.ws;
    if (blockIdx.x < 192) {
        LAS float* ca = (LAS float*)lds;
        LAS float* red = (LAS float*)(lds + 16384);
        const float* c = a.in[I_C];
        for (int i = tid; i < 4096; i += NT) ca[i] = silu_f(c[i]);
        __syncthreads();
        const int col = blockIdx.x * 64 + lane; const float* wm = a.in[I_WMOD] + col;
        float a0 = 0.f, a1 = 0.f;
        for (int k0 = wave * 256; k0 < wave * 256 + 256; k0 += 32) {
            float wv[32];
#pragma unroll
            for (int i = 0; i < 32; ++i) wv[i] = wm[(size_t)(k0 + i) * 12288];
#pragma unroll
            for (int i = 0; i < 32; ++i) { a0 += ca[k0 + i] * wv[i]; a1 += ca[2048 + k0 + i] * wv[i]; } }
        red[(wave * 2 + 0) * 64 + lane] = a0; red[(wave * 2 + 1) * 64 + lane] = a1;
        __syncthreads();
        if (tid < 128) { const int b = tid >> 6, l = tid & 63; float s = 0.f;
#pragma unroll
            for (int w = 0; w < 8; ++w) s += red[(w * 2 + b) * 64 + l];
            const int cc = blockIdx.x * 64 + l; ((float*)(ws + WS_MOD))[b * 12288 + cc] = s + a.in[I_BMOD][cc]; }
        __syncthreads();
    }
    LAS float* scr = (LAS float*)(lds + wave * 16384);
    const int gw = blockIdx.x * NWAVES + wave, NGW = gridDim.x * NWAVES;
    constexpr int IT_IN = 32 * 193, IT_OUT = 32 * 64, IT_UP = 32 * 352, IT_DN = 88 * 64;
    for (int it = gw; it < IT_IN + IT_OUT + IT_UP + IT_DN; it += NGW) {
        int r = it;
        if (r < IT_IN) { const int kb = r / 193, nb = r % 193; transpose_item(a.in[I_WIN], D, NIN_SRC, 64 * kb, 32 * nb, nb == 192 ? 16 : 32, (bf16*)(ws + WS_WIN), 32 * nb, scr, lane); continue; } r -= IT_IN;
        if (r < IT_OUT) { const int kb = r / 64, nb = r % 64; transpose_item(a.in[I_WOUT], D, D, 64 * kb, 32 * nb, 32, (bf16*)(ws + WS_WOUT), 32 * nb, scr, lane); continue; } r -= IT_OUT;
        if (r < IT_UP) { const int kb = r / 352, nb = r % 352; const int n0 = 32 * nb; const int jj = n0 < DFF ? n0 : n0 - DFF;
            const int drow = 256 * (jj >> 7) + (n0 < DFF ? 0 : 128) + (jj & 127);
            transpose_item(a.in[I_WUP], D, NUP, 64 * kb, n0, 32, (bf16*)(ws + WS_WUP), drow, scr, lane); continue; } r -= IT_UP;
        { const int kb = r / 64, nb = r % 64; transpose_item(a.in[I_WDN], DFF, D, 64 * kb, 32 * nb, 32, (bf16*)(ws + WS_WDN), 32 * nb, scr, lane); }
    }
}

__device__ __forceinline__ void phase_h1(const Args& a, int lane, int wave) {
    const float* mod = (const float*)(a.ws + WS_MOD); bf16* H = (bf16*)(a.ws + WS_H);
    const int NGW = gridDim.x * NWAVES;
    for (int rb = blockIdx.x * NWAVES + wave; rb < M / 16; rb += NGW) {
        const int m0 = rb * 16, b = m0 >> 14; const float* mb = mod + b * 12288;
        float A[4][8], B[4][8];
#pragma unroll
        for (int j = 0; j < 4; ++j)
#pragma unroll
            for (int e = 0; e < 8; ++e) { const int col = 512 * j + 8 * lane + e; A[j][e] = a.in[I_MIXPRE][col] * (1.0f + mb[2048 + col]); B[j][e] = mb[col]; }
        for (int r = 0; r < 16; ++r) {
            const float* xr = a.in[I_X] + (size_t)(m0 + r) * D + 8 * lane;
            f32x4 v[4][2]; float ss = 0.f;
#pragma unroll
            for (int j = 0; j < 4; ++j) { v[j][0] = *(const f32x4*)(xr + 512 * j); v[j][1] = *(const f32x4*)(xr + 512 * j + 4); }
#pragma unroll
            for (int j = 0; j < 4; ++j)
#pragma unroll
                for (int q = 0; q < 2; ++q) ss += (v[j][q].x * v[j][q].x + v[j][q].y * v[j][q].y) + (v[j][q].z * v[j][q].z + v[j][q].w * v[j][q].w);
            const float rstd = rsqrtf(wave_sum(ss) * (1.0f / D) + EPS);
            bf16* hr = H + (size_t)(m0 + r) * D + 8 * lane;
#pragma unroll
            for (int j = 0; j < 4; ++j) { float o[8];
#pragma unroll
                for (int e = 0; e < 8; ++e) o[e] = v[j][e >> 2][e & 3] * rstd * A[j][e] + B[j][e];
                *(v4u*)(hr + 512 * j) = pack8(o); }
        }
        asm volatile("s_waitcnt vmcnt(0)" ::: "memory");
        { const int r16 = lane & 15, q4 = lane >> 4;
          const bf16* hrow = H + (size_t)(m0 + r16) * D + 8 * q4; const bf16* wrow = (const bf16*)(a.ws + WS_WIN) + (size_t)(NIN + r16) * D + 8 * q4;
          f32x4 acc0 = (f32x4){0.f, 0.f, 0.f, 0.f}, acc1 = acc0;
#pragma unroll 4
          for (int ks = 0; ks < 64; ks += 2) {
              const bf16x8 a0 = *(const bf16x8*)(hrow + 32 * ks), b0 = *(const bf16x8*)(wrow + 32 * ks), a1 = *(const bf16x8*)(hrow + 32 * ks + 32), b1 = *(const bf16x8*)(wrow + 32 * ks + 32);
              acc0 = __builtin_amdgcn_mfma_f32_16x16x32_bf16(a0, b0, acc0, 0, 0, 0); acc1 = __builtin_amdgcn_mfma_f32_16x16x32_bf16(a1, b1, acc1, 0, 0, 0); }
          float* alr = (float*)(a.ws + WS_ALR);
#pragma unroll
          for (int x = 0; x < 4; ++x) alr[(size_t)(m0 + 4 * q4 + x) * 16 + r16] = acc0[x] + acc1[x]; }
    }
}

struct GateIn { f32x4 av; float w2r[16]; float gb; };
__device__ __forceinline__ void gates_load(const Args& a, int m0, int h, int tid, GateIn& g) {
    const float* alr = (const float*)(a.ws + WS_ALR) + (size_t)m0 * 16;
    g.av = (f32x4){0.f, 0.f, 0.f, 0.f};
    if (tid < 256) g.av = *(const f32x4*)(alr + 4 * tid);
    const int d = tid & 127;
#pragma unroll
    for (int r = 0; r < 16; ++r) g.w2r[r] = a.in[I_GW2][r * 512 + h * 128 + d];
    g.gb = a.in[I_GB][h * 128 + d];
}
__device__ __forceinline__ void gates_compute(const GateIn& g, LAS float* aL, LAS float* tot, int tid, float (&bq)[16], float& blast) {
    if (tid < 256) *(LAS f32x4*)(aL + 4 * tid) = g.av;
    const int d = tid & 127, ig = tid >> 7;
    __syncthreads();
    float run = 0.f;
#pragma unroll
    for (int ii = 0; ii < 16; ++ii) { const LAS f32x4* ar = (const LAS f32x4*)(aL + (16 * ig + ii) * 16); float z = g.gb;
#pragma unroll
        for (int r4 = 0; r4 < 4; ++r4) { const f32x4 av = ar[r4]; z += av.x * g.w2r[4 * r4] + av.y * g.w2r[4 * r4 + 1] + av.z * g.w2r[4 * r4 + 2] + av.w * g.w2r[4 * r4 + 3]; }
        const float ls = fminf(z, 0.f) - __logf(1.0f + __expf(-fabsf(z)));
        run += ls * (1.0f / 16.0f); bq[ii] = run; }
    tot[ig * 128 + d] = run;
    __syncthreads();
    float off = 0.f, all = 0.f;
#pragma unroll
    for (int gg = 0; gg < 4; ++gg) { const float t = tot[gg * 128 + d]; all += t; off += (gg < ig) ? t : 0.f; }
#pragma unroll
    for (int ii = 0; ii < 16; ++ii) bq[ii] += off;
    blast = all;
}

__device__ __forceinline__ void phase_g1(const Args& a, LAS unsigned char* lds, int tid, int lane, int wave) {
    LAS float* aL = (LAS float*)lds; LAS float* tot = (LAS float*)(lds + 4096); LAS bf16* kdT = (LAS bf16*)(lds + 8192);
    LAS bf16* Kr = (LAS bf16*)(lds + 26624); LAS bf16* Vs = (LAS bf16*)(lds + 44032);
    const bf16* proj = (const bf16*)(a.ws + WS_PROJ); bf16* S = (bf16*)(a.ws + WS_S); float* dec = (float*)(a.ws + WS_DEC);
    const int d = tid & 127, ig = tid >> 7, r16 = lane & 15, q4 = lane >> 4;
    for (int unit = blockIdx.x; unit < 2048; unit += gridDim.x) {
        const int bh = unit >> 8, n = unit & 255, b = bh >> 2, h = bh & 3, m0 = b * SEQ + n * 64;
        float bq[16], blast;
        GateIn gin; gates_load(a, m0, h, tid, gin);
        v4u kreg[2], vreg[4];
#pragma unroll
        for (int s2 = 0; s2 < 2; ++s2) { const int c = tid + 512 * s2; kreg[s2] = *(const v4u*)(proj + (size_t)(m0 + (c >> 4)) * NIN + C_K + h * 128 + 8 * (c & 15)); }
#pragma unroll
        for (int s4 = 0; s4 < 4; ++s4) { const int c = tid + 512 * s4; vreg[s4] = *(const v4u*)(proj + (size_t)(m0 + (c >> 5)) * NIN + C_V + h * 256 + 8 * (c & 31)); }
        gates_compute(gin, aL, tot, tid, bq, blast);
#pragma unroll
        for (int s2 = 0; s2 < 2; ++s2) { const int c = tid + 512 * s2; *(LAS v4u*)(Kr + (c >> 4) * 136 + 8 * (c & 15)) = kreg[s2]; }
#pragma unroll
        for (int s4 = 0; s4 < 4; ++s4) { const int c = tid + 512 * s4; *(LAS v4u*)(Vs + (c >> 5) * 264 + 8 * (c & 31)) = vreg[s4]; }
        __syncthreads();
        { float kd[16];
#pragma unroll
          for (int ii = 0; ii < 16; ++ii) kd[ii] = bf1(Kr[(16 * ig + ii) * 136 + d]) * __expf(blast - bq[ii]);
          v4u w0, w1; w0.x = pk2(kd[0], kd[1]); w0.y = pk2(kd[2], kd[3]); w0.z = pk2(kd[4], kd[5]); w0.w = pk2(kd[6], kd[7]);
          w1.x = pk2(kd[8], kd[9]); w1.y = pk2(kd[10], kd[11]); w1.z = pk2(kd[12], kd[13]); w1.w = pk2(kd[14], kd[15]);
          *(LAS v4u*)(kdT + d * 72 + 16 * ig) = w0; *(LAS v4u*)(kdT + d * 72 + 16 * ig + 8) = w1;
          if (ig == 0) dec[unit * 128 + d] = __expf(blast); }
        bf16x8 vf[2][2];
#pragma unroll
        for (int nt = 0; nt < 2; ++nt)
#pragma unroll
            for (int ks = 0; ks < 2; ++ks)
#pragma unroll
                for (int jj = 0; jj < 8; ++jj) vf[nt][ks][jj] = (short)Vs[(32 * ks + 8 * q4 + jj) * 264 + 32 * wave + 16 * nt + r16];
        __syncthreads();
        f32x4 acc[8][2];
#pragma unroll
        for (int mt = 0; mt < 8; ++mt)
#pragma unroll
            for (int nt = 0; nt < 2; ++nt) acc[mt][nt] = (f32x4){0.f, 0.f, 0.f, 0.f};
#pragma unroll
        for (int mt = 0; mt < 8; ++mt)
#pragma unroll
            for (int ks = 0; ks < 2; ++ks) { const bf16x8 af = *(const LAS bf16x8*)(kdT + (16 * mt + r16) * 72 + 32 * ks + 8 * q4);
#pragma unroll
                for (int nt = 0; nt < 2; ++nt) acc[mt][nt] = __builtin_amdgcn_mfma_f32_16x16x32_bf16(af, vf[nt][ks], acc[mt][nt], 0, 0, 0); }
        bf16* Su = S + (size_t)unit * 32768;
#pragma unroll
        for (int mt = 0; mt < 8; ++mt)
#pragma unroll
            for (int nt = 0; nt < 2; ++nt) { v2u w; w.x = pk2(acc[mt][nt][0], acc[mt][nt][1]); w.y = pk2(acc[mt][nt][2], acc[mt][nt][3]);
                *(v2u*)(Su + (32 * wave + 16 * nt + r16) * 128 + 16 * mt + 4 * q4) = w; }
        __syncthreads();
    }
    bf16* Y = (bf16*)(a.ws + WS_H);
    for (int item = blockIdx.x; item < M / 64; item += gridDim.x) {
        const int c0 = 8 * (tid & 127), mr = item * 64 + 16 * (tid >> 7);
        float w0[8], w1[8], w2[8], p1[8], p2[8];
#pragma unroll
        for (int e = 0; e < 8; ++e) { w0[e] = a.in[I_CONVW][c0 + e]; w1[e] = a.in[I_CONVW][1024 + c0 + e]; w2[e] = a.in[I_CONVW][2048 + c0 + e]; p1[e] = 0.f; p2[e] = 0.f; }
        if ((mr & (SEQ - 1)) != 0) {
            float c1[8], x1[8]; const bf16* r2 = proj + (size_t)(mr - 2) * NIN + c0; const bf16* r1 = proj + (size_t)(mr - 1) * NIN + c0;
            unpack8(*(const v4u*)(r2 + C_CC), c1); unpack8(*(const v4u*)(r2 + C_CX), x1);
#pragma unroll
            for (int e = 0; e < 8; ++e) p2[e] = c1[e] * x1[e];
            unpack8(*(const v4u*)(r1 + C_CC), c1); unpack8(*(const v4u*)(r1 + C_CX), x1);
#pragma unroll
            for (int e = 0; e < 8; ++e) p1[e] = c1[e] * x1[e];
        }
        for (int r0 = 0; r0 < 16; r0 += 4) {
            v4u rb[4], rc[4], rx[4];
#pragma unroll
            for (int q = 0; q < 4; ++q) { const bf16* rp = proj + (size_t)(mr + r0 + q) * NIN + c0; rb[q] = *(const v4u*)(rp + C_CB); rc[q] = *(const v4u*)(rp + C_CC); rx[q] = *(const v4u*)(rp + C_CX); }
#pragma unroll
            for (int q = 0; q < 4; ++q) { float cb[8], cc[8], cx[8], o[8];
                unpack8(rb[q], cb); unpack8(rc[q], cc); unpack8(rx[q], cx);
#pragma unroll
                for (int e = 0; e < 8; ++e) { const float p0 = cc[e] * cx[e]; o[e] = cb[e] * (w0[e] * p2[e] + w1[e] * p1[e] + w2[e] * p0); p2[e] = p1[e]; p1[e] = p0; }
                *(v4u*)(Y + (size_t)(mr + r0 + q) * D + c0) = pack8(o); }
        }
    }
}

__device__ __forceinline__ void phase_g2(const Args& a, int tid) {
    unsigned* S = (unsigned*)(a.ws + WS_S); const float* dec = (const float*)(a.ws + WS_DEC);
    const int total = gridDim.x * NT;
    for (int idx = blockIdx.x * NT + tid; idx < 8 * 16384; idx += total) {
        const int bh = idx >> 14, r = idx & 16383, d0 = (2 * r) & 127;
        float s0 = 0.f, s1 = 0.f;
        for (int n0 = 0; n0 < 256; n0 += 16) {
            unsigned w[16]; f32x2 dd[16];
#pragma unroll
            for (int i = 0; i < 16; ++i) { const int unit = bh * 256 + n0 + i; w[i] = S[(size_t)unit * 16384 + r]; dd[i] = *(const f32x2*)(dec + unit * 128 + d0); }
#pragma unroll
            for (int i = 0; i < 16; ++i) { const int unit = bh * 256 + n0 + i; S[(size_t)unit * 16384 + r] = pk2(s0, s1);
                s0 = dd[i].x * s0 + bflo(w[i]); s1 = dd[i].y * s1 + bfhi(w[i]); }
        }
    }
}

__device__ __forceinline__ void phase_g3(const Args& a, LAS unsigned char* lds, int tid, int lane, int wave) {
    LAS float* aL = (LAS float*)lds; LAS float* tot = (LAS float*)(lds + 4096); LAS float* part = (LAS float*)(lds + 6144); LAS float* rstdL = (LAS float*)(lds + 8192);
    LAS bf16* Qs = (LAS bf16*)(lds + 8704); LAS bf16* Ks = (LAS bf16*)(lds + 8704 + 17408); LAS bf16* Ps = (LAS bf16*)(lds + 8704 + 2 * 17408);
    LAS bf16* Vs = (LAS bf16*)(lds + 52736); LAS bf16* Rs = (LAS bf16*)(lds + 86528);
    const bf16* proj = (const bf16*)(a.ws + WS_PROJ); const bf16* S = (const bf16*)(a.ws + WS_S); bf16* Y = (bf16*)(a.ws + WS_H);
    const int d = tid & 127, ig = tid >> 7, r16 = lane & 15, q4 = lane >> 4;
    for (int unit = blockIdx.x; unit < 2048; unit += gridDim.x) {
        const int bh = unit >> 8, n = unit & 255, b = bh >> 2, h = bh & 3, m0 = b * SEQ + n * 64;
        float bq[16], blast;
        GateIn gin; gates_load(a, m0, h, tid, gin);
        v4u qreg[2], kreg[2], vreg[4], rreg[4];
#pragma unroll
        for (int s2 = 0; s2 < 2; ++s2) { const int c = tid + 512 * s2; const bf16* rp = proj + (size_t)(m0 + (c >> 4)) * NIN + h * 128 + 8 * (c & 15); qreg[s2] = *(const v4u*)(rp + C_Q); kreg[s2] = *(const v4u*)(rp + C_K); }
#pragma unroll
        for (int s4 = 0; s4 < 4; ++s4) { const int c = tid + 512 * s4; const bf16* rp = proj + (size_t)(m0 + (c >> 5)) * NIN + h * 256 + 8 * (c & 31); vreg[s4] = *(const v4u*)(rp + C_V); rreg[s4] = *(const v4u*)(rp + C_R); }
        const bf16* Su = S + (size_t)unit * 32768;
        bf16x8 sf[4][2];
#pragma unroll
        for (int ks = 0; ks < 4; ++ks)
#pragma unroll
            for (int nt = 0; nt < 2; ++nt) sf[ks][nt] = *(const bf16x8*)(Su + (32 * wave + 16 * nt + r16) * 128 + 32 * ks + 8 * q4);
        gates_compute(gin, aL, tot, tid, bq, blast);
#pragma unroll
        for (int s2 = 0; s2 < 2; ++s2) { const int c = tid + 512 * s2; *(LAS v4u*)(Qs + (c >> 4) * 136 + 8 * (c & 15)) = qreg[s2]; *(LAS v4u*)(Ks + (c >> 4) * 136 + 8 * (c & 15)) = kreg[s2]; }
#pragma unroll
        for (int s4 = 0; s4 < 4; ++s4) { const int c = tid + 512 * s4; *(LAS v4u*)(Vs + (c >> 5) * 264 + 8 * (c & 31)) = vreg[s4]; *(LAS v4u*)(Rs + (c >> 5) * 264 + 8 * (c & 31)) = rreg[s4]; }
        __syncthreads();
#pragma unroll
        for (int ii = 0; ii < 16; ++ii) { const int i = 16 * ig + ii;
            const float qv = bf1(Qs[i * 136 + d]), kv = bf1(Ks[i * 136 + d]);
            Qs[i * 136 + d] = (bf16)(pk2(qv * 0.08838834764831845f * __expf(bq[ii]), 0.f) & 0xffffu);
            Ks[i * 136 + d] = (bf16)(pk2(kv * __expf(-bq[ii]), 0.f) & 0xffffu); }
        bf16x8 vf[2][2];
#pragma unroll
        for (int nt = 0; nt < 2; ++nt)
#pragma unroll
            for (int ks = 0; ks < 2; ++ks)
#pragma unroll
                for (int jj = 0; jj < 8; ++jj) vf[nt][ks][jj] = (short)Vs[(32 * ks + 8 * q4 + jj) * 264 + 32 * wave + 16 * nt + r16];
        __syncthreads();
#pragma unroll
        for (int tt = 0; tt < 2; ++tt) { const int t = 2 * wave + tt, it = t >> 2, jt = t & 3;
            f32x4 sc = (f32x4){0.f, 0.f, 0.f, 0.f};
            if (jt <= it) {
#pragma unroll
                for (int ks = 0; ks < 4; ++ks) { const bf16x8 af = *(const LAS bf16x8*)(Qs + (16 * it + r16) * 136 + 32 * ks + 8 * q4); const bf16x8 bf = *(const LAS bf16x8*)(Ks + (16 * jt + r16) * 136 + 32 * ks + 8 * q4);
                    sc = __builtin_amdgcn_mfma_f32_16x16x32_bf16(af, bf, sc, 0, 0, 0); } }
#pragma unroll
            for (int x = 0; x < 4; ++x) { const int i = 16 * it + 4 * q4 + x, j = 16 * jt + r16; Ps[i * 72 + j] = (bf16)(pk2(j <= i ? sc[x] : 0.f, 0.f) & 0xffffu); } }
        __syncthreads();
        f32x4 acc[4][2];
#pragma unroll
        for (int mt = 0; mt < 4; ++mt)
#pragma unroll
            for (int nt = 0; nt < 2; ++nt) acc[mt][nt] = (f32x4){0.f, 0.f, 0.f, 0.f};
#pragma unroll
        for (int ks = 0; ks < 2; ++ks)
#pragma unroll
            for (int mt = 0; mt < 4; ++mt) { const bf16x8 af = *(const LAS bf16x8*)(Ps + (16 * mt + r16) * 72 + 32 * ks + 8 * q4);
#pragma unroll
                for (int nt = 0; nt < 2; ++nt) acc[mt][nt] = __builtin_amdgcn_mfma_f32_16x16x32_bf16(af, vf[nt][ks], acc[mt][nt], 0, 0, 0); }
#pragma unroll
        for (int ks = 0; ks < 4; ++ks) {
#pragma unroll
            for (int mt = 0; mt < 4; ++mt) { const bf16x8 af = *(const LAS bf16x8*)(Qs + (16 * mt + r16) * 136 + 32 * ks + 8 * q4);
#pragma unroll
                for (int nt = 0; nt < 2; ++nt) acc[mt][nt] = __builtin_amdgcn_mfma_f32_16x16x32_bf16(af, sf[ks][nt], acc[mt][nt], 0, 0, 0); } }
#pragma unroll
        for (int mt = 0; mt < 4; ++mt)
#pragma unroll
            for (int x = 0; x < 4; ++x) { float ss = acc[mt][0][x] * acc[mt][0][x] + acc[mt][1][x] * acc[mt][1][x];
                ss += __shfl_xor(ss, 1); ss += __shfl_xor(ss, 2); ss += __shfl_xor(ss, 4); ss += __shfl_xor(ss, 8);
                if (r16 == 0) part[wave * 64 + 16 * mt + 4 * q4 + x] = ss; }
        __syncthreads();
        if (tid < 64) { float s = 0.f;
#pragma unroll
            for (int w = 0; w < 8; ++w) s += part[w * 64 + tid];
            rstdL[tid] = rsqrtf(s * (1.0f / 256.0f) + EPS); }
        __syncthreads();
#pragma unroll
        for (int nt = 0; nt < 2; ++nt) { const int e = 32 * wave + 16 * nt + r16; const float gw = a.in[I_GNW][e];
#pragma unroll
            for (int mt = 0; mt < 4; ++mt)
#pragma unroll
                for (int x = 0; x < 4; ++x) { const int i = 16 * mt + 4 * q4 + x; const float rr = bf1(Rs[i * 264 + e]);
                    const float y = acc[mt][nt][x] * rstdL[i] * gw * silu_f(rr);
                    Rs[i * 264 + e] = (bf16)(pk2(y, 0.f) & 0xffffu); } }
        __syncthreads();
#pragma unroll
        for (int s4 = 0; s4 < 4; ++s4) { const int c = tid + 512 * s4; *(v4u*)(Y + (size_t)(m0 + (c >> 5)) * D + 1024 + h * 256 + 8 * (c & 31)) = *(const LAS v4u*)(Rs + (c >> 5) * 264 + 8 * (c & 31)); }
        __syncthreads();
    }
}

__device__ __forceinline__ void phase_mid(const Args& a, int lane, int wave) {
    const float* mod = (const float*)(a.ws + WS_MOD); bf16* H = (bf16*)(a.ws + WS_H); const bf16* Yb = (const bf16*)(a.ws + WS_Y);
    const int NGW = gridDim.x * NWAVES;
    for (int rb = blockIdx.x * NWAVES + wave; rb < M / 16; rb += NGW) {
        const int m0 = rb * 16, b = m0 >> 14; const float* mb = mod + b * 12288;
        float G[4][8], A[4][8], B[4][8];
#pragma unroll
        for (int j = 0; j < 4; ++j)
#pragma unroll
            for (int e = 0; e < 8; ++e) { const int col = 512 * j + 8 * lane + e; G[j][e] = mb[4096 + col] * a.in[I_MIXPOST][col];
                A[j][e] = a.in[I_FPRE][col] * (1.0f + mb[8192 + col]); B[j][e] = mb[6144 + col]; }
        for (int r = 0; r < 16; ++r) {
            const size_t ro = (size_t)(m0 + r) * D + 8 * lane;
            float y[4][8]; float ss = 0.f;
#pragma unroll
            for (int j = 0; j < 4; ++j) { unpack8(*(const v4u*)(Yb + ro + 512 * j), y[j]);
#pragma unroll
                for (int e = 0; e < 8; ++e) ss += y[j][e] * y[j][e]; }
            const float rstd = rsqrtf(wave_sum(ss) * (1.0f / D) + EPS);
            float s2 = 0.f;
#pragma unroll
            for (int j = 0; j < 4; ++j) { const f32x4 xa = *(const f32x4*)(a.in[I_X] + ro + 512 * j), xb = *(const f32x4*)(a.in[I_X] + ro + 512 * j + 4);
#pragma unroll
                for (int e = 0; e < 8; ++e) { const float xv = (e < 4 ? xa[e & 3] : xb[e & 3]) + G[j][e] * (y[j][e] * rstd); y[j][e] = xv; s2 += xv * xv; }
                *(f32x4*)(a.out + ro + 512 * j) = (f32x4){y[j][0], y[j][1], y[j][2], y[j][3]}; *(f32x4*)(a.out + ro + 512 * j + 4) = (f32x4){y[j][4], y[j][5], y[j][6], y[j][7]}; }
            const float rstd2 = rsqrtf(wave_sum(s2) * (1.0f / D) + EPS);
#pragma unroll
            for (int j = 0; j < 4; ++j) { float o[8];
#pragma unroll
                for (int e = 0; e < 8; ++e) o[e] = y[j][e] * rstd2 * A[j][e] + B[j][e];
                *(v4u*)(H + ro + 512 * j) = pack8(o); }
        }
    }
}

__device__ __forceinline__ void phase_fixup(const Args& a, int tid) {
    const bf16* HALO = (const bf16*)(a.ws + WS_HALO); bf16* ACT = (bf16*)(a.ws + WS_ACT); const float* cw = a.in[I_FCONVW];
    const int total = gridDim.x * NT;
    for (int item = blockIdx.x * NT + tid; item < 512 * 2 * 704; item += total) {
        const int cg = item % 704, gl = item / 704, lr = gl & 1, G = gl >> 1, j0 = 8 * cg, uc = 256 * (j0 >> 7) + (j0 & 127);
        const bool first = (G & 255) == 0;
        const bf16* hc = HALO + ((size_t)G * 4 + lr) * NUP + uc;
        const bf16* h1 = lr == 0 ? HALO + ((size_t)(G - 1) * 4 + 3) * NUP + uc : HALO + ((size_t)G * 4 + 0) * NUP + uc;
        const bf16* h2 = lr == 0 ? HALO + ((size_t)(G - 1) * 4 + 2) * NUP + uc : HALO + ((size_t)(G - 1) * 4 + 3) * NUP + uc;
        float g0[8], v0[8], g1[8], v1[8], g2[8], v2[8], o[8];
        unpack8(*(const v4u*)hc, g0); unpack8(*(const v4u*)(hc + 128), v0);
#pragma unroll
        for (int e = 0; e < 8; ++e) { g1[e] = 0.f; v1[e] = 0.f; g2[e] = 0.f; v2[e] = 0.f; }
        if (!(first && lr == 0)) { unpack8(*(const v4u*)h1, g1); unpack8(*(const v4u*)(h1 + 128), v1); }
        if (!first) { unpack8(*(const v4u*)h2, g2); unpack8(*(const v4u*)(h2 + 128), v2); }
#pragma unroll
        for (int e = 0; e < 8; ++e) { const float gg = cw[j0 + e] * g2[e] + cw[NUP + j0 + e] * g1[e] + cw[2 * NUP + j0 + e] * g0[e];
            const float vv = cw[DFF + j0 + e] * v2[e] + cw[NUP + DFF + j0 + e] * v1[e] + cw[2 * NUP + DFF + j0 + e] * v0[e];
            o[e] = silu_f(gg) * vv; }
        *(v4u*)(ACT + (size_t)(G * 64 + lr) * DFF + j0) = pack8(o);
    }
}

__device__ __forceinline__ void phase_final(const Args& a, int lane, int wave) {
    const float* mod = (const float*)(a.ws + WS_MOD); const bf16* Yb = (const bf16*)(a.ws + WS_Y2);
    const int NGW = gridDim.x * NWAVES;
    for (int rb = blockIdx.x * NWAVES + wave; rb < M / 16; rb += NGW) {
        const int m0 = rb * 16, b = m0 >> 14; const float* mb = mod + b * 12288;
        float G[4][8];
#pragma unroll
        for (int j = 0; j < 4; ++j)
#pragma unroll
            for (int e = 0; e < 8; ++e) { const int col = 512 * j + 8 * lane + e; G[j][e] = mb[10240 + col] * a.in[I_FPOST][col]; }
        for (int r = 0; r < 16; ++r) {
            const size_t ro = (size_t)(m0 + r) * D + 8 * lane;
            float y[4][8]; float ss = 0.f;
#pragma unroll
            for (int j = 0; j < 4; ++j) { unpack8(*(const v4u*)(Yb + ro + 512 * j), y[j]);
#pragma unroll
                for (int e = 0; e < 8; ++e) ss += y[j][e] * y[j][e]; }
            const float rstd = rsqrtf(wave_sum(ss) * (1.0f / D) + EPS);
#pragma unroll
            for (int j = 0; j < 4; ++j) { f32x4 xa = *(const f32x4*)(a.out + ro + 512 * j), xb = *(const f32x4*)(a.out + ro + 512 * j + 4);
#pragma unroll
                for (int e = 0; e < 4; ++e) { xa[e] += G[j][e] * (y[j][e] * rstd); xb[e] += G[j][e + 4] * (y[j][e + 4] * rstd); }
                *(f32x4*)(a.out + ro + 512 * j) = xa; *(f32x4*)(a.out + ro + 512 * j + 4) = xb; }
        }
    }
}

#define RLX_AGENT __ATOMIC_RELAXED, __HIP_MEMORY_SCOPE_AGENT
#define XB_TMO      128
#define XB_XCNT(j)  (256  + 64 * (j))
#define XB_XSUB(j)  (1280 + 64 * (j))
#define XB_XGEN(j)  (2304 + 64 * (j))
#define XB_TOP      3328
#define XB_TOPGEN   3392
#define XCD_BAR_WORDS 3456
#define XB_SPIN_CAP (1u << 18)

__device__ __forceinline__ unsigned xb_ld(unsigned* p)              { return __hip_atomic_load(p, __ATOMIC_RELAXED, __HIP_MEMORY_SCOPE_AGENT); }
__device__ __forceinline__ unsigned xb_add(unsigned* p, unsigned v) { return __hip_atomic_fetch_add(p, v, __ATOMIC_RELAXED, __HIP_MEMORY_SCOPE_AGENT); }
__device__ __forceinline__ unsigned xb_xcc_id() { return (unsigned)__builtin_amdgcn_s_getreg((3 << 11) | 20) & 0xFu; }
#define XB_SPIN(cond, bar) do { unsigned _sp = 0; while (cond) { __builtin_amdgcn_s_sleep(1); \
    if ((++_sp & 255u) == 0u) { if (xb_ld(&(bar)[XB_TMO])) break; if (_sp > XB_SPIN_CAP) { atomicAdd(&(bar)[XB_TMO], 1u); break; } } } } while (0)

struct XcdBarrier {
    unsigned* bar; unsigned x;
    volatile LAS unsigned* st;
};

__device__ __forceinline__ XcdBarrier xcd_barrier_post(unsigned* bar, volatile LAS unsigned* st) {
    XcdBarrier b; b.bar = bar; b.x = xb_xcc_id(); b.st = st;
    if (threadIdx.x == 0) (void)xb_add(&bar[XB_XCNT(b.x)], 1u);
    return b;
}
__device__ __forceinline__ void xcd_barrier_complete(unsigned* bar, unsigned x, unsigned& nloc, unsigned& nx) {
    const unsigned G = gridDim.x * gridDim.y * gridDim.z;
    unsigned sum, cnt, mine, sp = 0u;
    for (;;) {
        sum = 0u; cnt = 0u; mine = 0u;
#pragma unroll
        for (unsigned j = 0; j < 16; ++j) { const unsigned c = xb_ld(&bar[XB_XCNT(j)]); sum += c; cnt += (c > 0u) ? 1u : 0u; mine = (j == x) ? c : mine; }
        if (sum == G) break;
        __builtin_amdgcn_s_sleep(1);
        if ((++sp & 255u) == 0u) { if (xb_ld(&bar[XB_TMO])) break; if (sp > XB_SPIN_CAP) { atomicAdd(&bar[XB_TMO], 1u); break; } }
    }
    nloc = mine > 0u ? mine : 1u; nx = cnt > 0u ? cnt : 1u;
}

__device__ __forceinline__ void xcd_barrier(const XcdBarrier& b) {
    asm volatile("s_waitcnt vmcnt(0)" ::: "memory");
    __syncthreads();
    if (threadIdx.x == 0) {
        unsigned* bar = b.bar;
        __builtin_amdgcn_s_waitcnt(0);
        unsigned nloc = b.st[0], nx = b.st[1];
        if (nloc == 0u) { xcd_barrier_complete(bar, b.x, nloc, nx); b.st[0] = nloc; b.st[1] = nx; }
        const unsigned old = xb_add(&bar[XB_XSUB(b.x)], 1u);
        const unsigned gen = old / nloc;
        if (old + 1u == (gen + 1u) * nloc) {
            __builtin_amdgcn_fence(__ATOMIC_RELEASE, "agent");
            asm volatile("s_waitcnt vmcnt(0)" ::: "memory");
            const unsigned og = xb_add(&bar[XB_TOP], 1u);
            const unsigned tg = og / nx;
            if (og + 1u == (tg + 1u) * nx) xb_add(&bar[XB_TOPGEN], 1u);
            else XB_SPIN(xb_ld(&bar[XB_TOPGEN]) == tg, bar);
            __builtin_amdgcn_fence(__ATOMIC_ACQUIRE, "agent");
            xb_add(&bar[XB_XGEN(b.x)], 1u);
            asm volatile("s_waitcnt vmcnt(0)" ::: "memory");
        } else {
            XB_SPIN(xb_ld(&bar[XB_XGEN(b.x)]) == gen, bar);
            __builtin_amdgcn_fence(__ATOMIC_ACQUIRE, "agent");
            asm volatile("s_waitcnt vmcnt(0)" ::: "memory");
        }
    }
    __syncthreads();
}

constexpr int N_PHASES = 12;
#ifndef REP_GEMM
#define REP_GEMM 1
#endif
#ifndef REP_A
#define REP_A 1
#endif
#ifndef REP_B
#define REP_B 1
#endif
#ifndef REP_C
#define REP_C 1
#endif
__global__ void __launch_bounds__(NT, 2) fwd_kernel(Args args) {
    extern __shared__ __attribute__((aligned(16))) unsigned char lds_raw[];
    LAS unsigned char* lds = (LAS unsigned char*)lds_raw;
    const int tid = threadIdx.x, lane = tid & 63, wave = __builtin_amdgcn_readfirstlane(tid >> 6);
    const int lo = args.ph_lo, hi = args.ph_hi; unsigned char* ws = args.ws;
    volatile LAS unsigned* bst = (volatile LAS unsigned*)(lds + LDS_BYTES - 64);
    if (tid < 2) bst[tid] = 0u;
    __syncthreads();
    XcdBarrier xbar; xbar.bar = (unsigned*)ws; xbar.x = 0; xbar.st = nullptr;
    if (hi - lo > 1) xbar = xcd_barrier_post((unsigned*)ws, bst);
    if (lo < 0) cg::this_grid().sync();
#define IN(k) (lo <= (k) && (k) < hi)
#define SEAM(k) do { if (IN(k) && IN((k) + 1)) { xcd_barrier(xbar); } } while (0)
    if (IN(0)) { for (int rep = 0; rep < REP_A; ++rep) { phase_prologue(args, lds, tid, lane, wave); __syncthreads(); } } SEAM(0);
    if (IN(1)) { for (int rep = 0; rep < REP_A; ++rep) { phase_h1(args, lane, wave); __syncthreads(); } } SEAM(1);
    if (IN(2)) { pg8::Gemm g{(const bf16*)(ws + WS_H), (const bf16*)(ws + WS_WIN), M, NIN, D}; pg8::StaticOrder S; S.init(M, NIN, gridDim.x, blockIdx.x);
        pg8::EpiB16 E{(bf16*)(ws + WS_PROJ), NIN};
        _Pragma("unroll") for (int rep = 0; rep < REP_GEMM; ++rep) { pg8::gemm_phase<pg8::EpiB16, pg8::StaticOrder, true, true>(lds, g, S, E); __syncthreads(); } } SEAM(2);
    if (IN(3)) { for (int rep = 0; rep < REP_B; ++rep) { phase_g1(args, lds, tid, lane, wave); __syncthreads(); } } SEAM(3);
    if (IN(4)) { phase_g2(args, tid); } SEAM(4);
    if (IN(5)) { for (int rep = 0; rep < REP_B; ++rep) { phase_g3(args, lds, tid, lane, wave); __syncthreads(); } } SEAM(5);
    if (IN(6)) { pg8::Gemm g{(const bf16*)(ws + WS_H), (const bf16*)(ws + WS_WOUT), M, D, D}; pg8::StaticOrder S; S.init(M, D, gridDim.x, blockIdx.x);
        pg8::EpiB16 E{(bf16*)(ws + WS_Y), D};
        _Pragma("unroll") for (int rep = 0; rep < REP_GEMM; ++rep) { pg8::gemm_phase<pg8::EpiB16, pg8::StaticOrder, true, true>(lds, g, S, E); __syncthreads(); } } SEAM(6);
    if (IN(7)) { for (int rep = 0; rep < REP_A; ++rep) { phase_mid(args, lane, wave); __syncthreads(); } } SEAM(7);
    if (IN(8)) { pg8::Gemm g{(const bf16*)(ws + WS_H), (const bf16*)(ws + WS_WUP), M, NUP, D}; pg8::StaticOrder S; S.init(M, NUP, gridDim.x, blockIdx.x);
        pg8::EpiConvGate E{(bf16*)(ws + WS_ACT), (bf16*)(ws + WS_HALO), args.in[I_FCONVW]};
        _Pragma("unroll") for (int rep = 0; rep < REP_GEMM; ++rep) { pg8::gemm_phase<pg8::EpiConvGate, pg8::StaticOrder, true, true>(lds, g, S, E); __syncthreads(); } } SEAM(8);
    if (IN(9)) { phase_fixup(args, tid); } SEAM(9);
    if (IN(10)) { pg8::Gemm g{(const bf16*)(ws + WS_ACT), (const bf16*)(ws + WS_WDN), M, D, DFF}; pg8::StaticOrder S; S.init(M, D, gridDim.x, blockIdx.x);
        pg8::EpiB16 E{(bf16*)(ws + WS_Y2), D};
        _Pragma("unroll") for (int rep = 0; rep < REP_GEMM; ++rep) { pg8::gemm_phase<pg8::EpiB16, pg8::StaticOrder, true, true>(lds, g, S, E); __syncthreads(); } } SEAM(10);
    if (IN(11)) { phase_final(args, lane, wave); }
#undef IN
#undef SEAM
}

#ifndef N_LAUNCH_MODE
#define N_LAUNCH_MODE 1
#endif
extern "C" void kernel_launch(void* const* d_in, const int* in_sizes, int n_in, void* d_out, int out_size, void* d_ws, size_t ws_size, hipStream_t stream) {
    static int grid = 0;
    if (grid == 0) {
        if (n_in != 17 || out_size != M * D || ws_size < WS_END) { fprintf(stderr, "kernel_launch: unexpected shapes (n_in %d out %d ws %zu)\n", n_in, out_size, ws_size); grid = -1; return; }
        int dev = 0, cus = 0, per_cu = 0;
        hipGetDevice(&dev); hipDeviceGetAttribute(&cus, hipDeviceAttributeMultiprocessorCount, dev);
        hipFuncSetAttribute((const void*)fwd_kernel, hipFuncAttributeMaxDynamicSharedMemorySize, LDS_BYTES);
        hipOccupancyMaxActiveBlocksPerMultiprocessor(&per_cu, (const void*)fwd_kernel, NT, LDS_BYTES);
        if (per_cu < 1) { fprintf(stderr, "kernel_launch: occupancy query says %d blocks per CU\n", per_cu); per_cu = 1; }
        (void)hipGetLastError();
        grid = cus * per_cu;
        fprintf(stderr, "kernel_launch: grid %d (cus %d x %d)\n", grid, cus, per_cu);
    }
    if (grid < 0) return;
    Args a{};
    for (int i = 0; i < 17; ++i) a.in[i] = (const float*)d_in[i];
    a.out = (float*)d_out; a.ws = (unsigned char*)d_ws;
#if N_LAUNCH_MODE == 1
    a.ph_lo = 0; a.ph_hi = N_PHASES;
    (void)hipMemsetAsync(d_ws, 0, 16384, stream);
    void* kargs[] = {&a};
    hipError_t e = hipLaunchCooperativeKernel((const void*)fwd_kernel, dim3(grid), dim3(NT), kargs, LDS_BYTES, stream);
    if (e != hipSuccess) fprintf(stderr, "cooperative launch failed: %s (grid %d)\n", hipGetErrorString(e), grid);
#else
    for (int p = 0; p < N_PHASES; ++p) { a.ph_lo = p; a.ph_hi = p + 1; hipLaunchKernelGGL(fwd_kernel, dim3(grid), dim3(NT), LDS_BYTES, stream, a); }
#endif
}
```

```cpp
#include <hip/hip_runtime.h>
#include <hip/hip_cooperative_groups.h>
#include <cstdio>
#include <cstdint>
namespace cg = cooperative_groups;
namespace pg8 {
#define PG8_LAS __attribute__((address_space(3)))
typedef unsigned short bf16_t;
typedef short bf16x8 __attribute__((ext_vector_type(8)));
typedef float f32x4 __attribute__((ext_vector_type(4)));
typedef unsigned u32x4 __attribute__((ext_vector_type(4)));
typedef unsigned u32x2 __attribute__((ext_vector_type(2)));
typedef float f32x2 __attribute__((ext_vector_type(2)));
constexpr int BM = 256, BK = 64, HALF = 128, HTB = HALF * BK * 2  , STAGE_BYTES = 8 * HTB, NXCD = 8, WGM = 8;

__host__ __device__ __forceinline__ int lds_byte(int r, int c) { const int st = (r >> 4) * 2 + (c >> 5), rr = r & 15, cc = c & 31, ob = rr * 64 + cc * 2; return st * 1024 + (ob ^ (((ob >> 9) & 1) << 5)); }
__host__ __device__ __forceinline__ void stage_rc(int b, int& R, int& C) { const int st = b / 1024, sb = b % 1024, swz = sb ^ (((sb >> 9) & 1) << 5); R = (st >> 1) * 16 + swz / 64; C = (st & 1) * 32 + (swz % 64) / 2; }
__host__ __device__ __forceinline__ int perm32(int rho) { const int n = rho >> 4, i = rho & 15; return 8 * (i >> 2) + 4 * n + (i & 3); }

struct Unit { int pm, pn; };
struct Gemm { const bf16_t* A; const bf16_t* Bt; int M, N, K; };

struct StaticOrder {
    int nM, nN, nwg, G, c;
    __host__ __device__ void init(int M, int N, int G_, int c_) { nM = M / BM; nN = N / BM; nwg = nM * nN; G = G_; c = c_; }
    __host__ __device__ bool next(int i, Unit& u) const {
        const long L = (long)i * G + c; if (L >= nwg) return false;
        int wgid = (int)L; { const int q = nwg / NXCD, r = nwg % NXCD, xcd = wgid % NXCD, off = wgid / NXCD; wgid = (xcd < r ? xcd * (q + 1) : r * (q + 1) + (xcd - r) * q) + off; }
        const int nig = WGM * nN, gid = wgid / nig, fm = gid * WGM, gsz = (nM - fm) < WGM ? (nM - fm) : WGM;
        u.pm = fm + ((wgid % nig) % gsz); u.pn = (wgid % nig) / gsz; return true;
    }
    __device__ __forceinline__ void a_ready(const Unit&) const {}
    __device__ __forceinline__ void done(const Unit&) const {}
};

__device__ __forceinline__ unsigned cvt_pk_bf16(float lo, float hi) { unsigned r; asm volatile("v_cvt_pk_bf16_f32 %0, %1, %2" : "=v"(r) : "v"(lo), "v"(hi)); return r; }
typedef float cvt_f32x2_t __attribute__((ext_vector_type(2))); typedef __bf16 cvt_bf16x2_t __attribute__((ext_vector_type(2)));
__device__ __forceinline__ unsigned cvt_pk_bf16_safe(float lo, float hi) { cvt_f32x2_t v = {lo, hi}; cvt_bf16x2_t b = __builtin_convertvector(v, cvt_bf16x2_t); return __builtin_bit_cast(unsigned, b); }
#define PG8_MFMA_SETTLE() asm volatile("s_nop 7\n\ts_nop 7\n\ts_nop 7" ::: "memory")
struct EpiB16 {
    static constexpr bool PERM = true, AFTER_DRAIN = false;
    bf16_t* O; int ldc;
    __device__ __forceinline__ void operator()(const f32x4 (&acc)[2][2][4][2], const Unit& u, int wr, int wc, int fr, int fq) const {
        PG8_MFMA_SETTLE();
        const int row0 = u.pm * BM + wr * 64 + fr, col0 = u.pn * BM + wc * 32 + 8 * fq;
#pragma unroll
        for (int ai = 0; ai < 2; ++ai)
#pragma unroll
            for (int m = 0; m < 4; ++m) { bf16_t* rowp = O + (size_t)(row0 + ai * HALF + m * 16) * ldc + col0;
#pragma unroll
                for (int bj = 0; bj < 2; ++bj) { const f32x4 v0 = acc[ai][bj][m][0], v1 = acc[ai][bj][m][1];
                    u32x4 w; w.x = cvt_pk_bf16(v0[0], v0[1]); w.y = cvt_pk_bf16(v0[2], v0[3]); w.z = cvt_pk_bf16(v1[0], v1[1]); w.w = cvt_pk_bf16(v1[2], v1[3]);
                    *(u32x4*)(rowp + bj * HALF) = w; } }
    }
};
struct EpiProj {
    static constexpr bool PERM = true, AFTER_DRAIN = false;
    bf16_t* O; float* alr;
    __device__ __forceinline__ void operator()(const f32x4 (&acc)[2][2][4][2], const Unit& u, int wr, int wc, int fr, int fq) const {
        PG8_MFMA_SETTLE();
        const int row0 = u.pm * BM + wr * 64 + fr;
        if (u.pn < 24) {
            const int col0 = u.pn * BM + wc * 32 + 8 * fq;
#pragma unroll
            for (int ai = 0; ai < 2; ++ai)
#pragma unroll
                for (int m = 0; m < 4; ++m) { bf16_t* rowp = O + (size_t)(row0 + ai * HALF + m * 16) * 6144 + col0;
#pragma unroll
                    for (int bj = 0; bj < 2; ++bj) { const f32x4 v0 = acc[ai][bj][m][0], v1 = acc[ai][bj][m][1];
                        u32x4 w; w.x = cvt_pk_bf16(v0[0], v0[1]); w.y = cvt_pk_bf16(v0[2], v0[3]); w.z = cvt_pk_bf16(v1[0], v1[1]); w.w = cvt_pk_bf16(v1[2], v1[3]);
                        *(u32x4*)(rowp + bj * HALF) = w; } }
        } else if (wc == 0 && fq < 2) {
#pragma unroll
            for (int ai = 0; ai < 2; ++ai)
#pragma unroll
                for (int m = 0; m < 4; ++m) { float* rp = alr + (size_t)(row0 + ai * HALF + m * 16) * 16 + 8 * fq;
                    *(f32x4*)rp = acc[ai][0][m][0]; *(f32x4*)(rp + 4) = acc[ai][0][m][1]; }
        }
    }
};

template <int CTRL> __device__ __forceinline__ float dpp_ror(float v) { return __builtin_bit_cast(float, __builtin_amdgcn_update_dpp(0, __builtin_bit_cast(int, v), CTRL, 0xf, 0xf, false)); }
struct EpiConvGate {
    static constexpr bool PERM = true, AFTER_DRAIN = false;
    bf16_t* ACT; bf16_t* HALO; const float* cw;
    __device__ __forceinline__ void operator()(const f32x4 (&acc)[2][2][4][2], const Unit& u, int wr, int wc, int fr, int fq) const {
        PG8_MFMA_SETTLE();
        constexpr int NUPc = 11264, DFFc = 5632;
        const int j0 = u.pn * 128 + wc * 32 + 8 * fq;
        const int ucol = u.pn * BM + wc * 32 + 8 * fq;
        f32x4 wg[2][3], wv[2][3];
#pragma unroll
        for (int k = 0; k < 3; ++k) { wg[0][k] = *(const f32x4*)(cw + k * NUPc + j0); wv[0][k] = *(const f32x4*)(cw + k * NUPc + DFFc + j0); }
#pragma unroll
        for (int ai = 0; ai < 2; ++ai) {
            const int grp = u.pm * 4 + ai * 2 + wr;
            if (fr < 2 || fr >= 14) { const int rr = fr < 2 ? fr : fr - 12; bf16_t* hp = HALO + ((size_t)grp * 4 + rr) * NUPc + ucol;
#pragma unroll
                for (int bj = 0; bj < 2; ++bj) { const f32x4 v0 = fr < 2 ? acc[ai][bj][0][0] : acc[ai][bj][3][0], v1 = fr < 2 ? acc[ai][bj][0][1] : acc[ai][bj][3][1];
                    u32x4 w; w.x = cvt_pk_bf16(v0[0], v0[1]); w.y = cvt_pk_bf16(v0[2], v0[3]); w.z = cvt_pk_bf16(v1[0], v1[1]); w.w = cvt_pk_bf16(v1[2], v1[3]);
                    *(u32x4*)(hp + bj * HALF) = w; } }
        }
#pragma unroll
        for (int n = 0; n < 2; ++n) {
            if (n == 1) {
                asm volatile("" ::: "memory"); __builtin_amdgcn_sched_barrier(0);
#pragma unroll
                for (int k = 0; k < 3; ++k) { wg[1][k] = *(const f32x4*)(cw + k * NUPc + j0 + 4); wv[1][k] = *(const f32x4*)(cw + k * NUPc + DFFc + j0 + 4); } }
#pragma unroll
            for (int ai = 0; ai < 2; ++ai) {
                __builtin_amdgcn_sched_barrier(0);
                const int jc = j0 + 4 * n;
                f32x2 o[4][2];
#pragma unroll
                for (int xp = 0; xp < 2; ++xp) {
                    const f32x2 a0 = (f32x2){wg[n][0][2 * xp], wg[n][0][2 * xp + 1]}, a1 = (f32x2){wg[n][1][2 * xp], wg[n][1][2 * xp + 1]}, a2 = (f32x2){wg[n][2][2 * xp], wg[n][2][2 * xp + 1]};
                    const f32x2 b0 = (f32x2){wv[n][0][2 * xp], wv[n][0][2 * xp + 1]}, b1 = (f32x2){wv[n][1][2 * xp], wv[n][1][2 * xp + 1]}, b2 = (f32x2){wv[n][2][2 * xp], wv[n][2][2 * xp + 1]};
                    f32x2 g1p = (f32x2){0.f, 0.f}, g2p = g1p, v1p = g1p, v2p = g1p;
#pragma unroll
                    for (int m = 0; m < 4; ++m) {
                        const f32x2 g = (f32x2){acc[ai][0][m][n][2 * xp], acc[ai][0][m][n][2 * xp + 1]}, v = (f32x2){acc[ai][1][m][n][2 * xp], acc[ai][1][m][n][2 * xp + 1]};
                        f32x2 g1, g2, v1, v2, ga, gb, va, vb;
#pragma unroll
                        for (int c = 0; c < 2; ++c) { g1[c] = dpp_ror<0x121>(g[c]); g2[c] = dpp_ror<0x122>(g[c]); v1[c] = dpp_ror<0x121>(v[c]); v2[c] = dpp_ror<0x122>(v[c]);
                            ga[c] = fr == 0 ? g1p[c] : g1[c]; gb[c] = fr < 2 ? g2p[c] : g2[c]; va[c] = fr == 0 ? v1p[c] : v1[c]; vb[c] = fr < 2 ? v2p[c] : v2[c]; }
                        const f32x2 G = a0 * gb + a1 * ga + a2 * g, V = b0 * vb + b1 * va + b2 * v;
                        const f32x2 t = G * (-1.4426950408889634f);
                        f32x2 e; e.x = __builtin_amdgcn_exp2f(t.x); e.y = __builtin_amdgcn_exp2f(t.y);
                        const f32x2 dn = e + 1.0f;
                        f32x2 rc; rc.x = __builtin_amdgcn_rcpf(dn.x); rc.y = __builtin_amdgcn_rcpf(dn.y);
                        o[m][xp] = (G * rc) * V;
                        g1p = g1; g2p = g2; v1p = v1; v2p = v2;
                    }
                }
#pragma unroll
                for (int m = 0; m < 4; ++m) { const int row = u.pm * BM + ai * HALF + wr * 64 + m * 16 + fr;
                    u32x2 w; w.x = cvt_pk_bf16(o[m][0].x, o[m][0].y); w.y = cvt_pk_bf16(o[m][1].x, o[m][1].y);
                    if (m > 0 || fr >= 2) *(u32x2*)(ACT + (size_t)row * DFFc + jc) = w; }
            }
        }
    }
};

template <class Epi, class Sched, bool ALIGN_EPI = false, bool SP2 = false>
__device__ __forceinline__ void gemm_phase(PG8_LAS unsigned char* lds, const Gemm g, const Sched& S, const Epi& E) {
    const int tid = threadIdx.x, wid = __builtin_amdgcn_readfirstlane(tid >> 6), lane = tid & 63, wr = wid >> 2, wc = wid & 3, fr = lane & 15, fq = lane >> 4;
    const int K = g.K, nt = K / BK;
    unsigned voffA[2], voffB[2];
#pragma unroll
    for (int i = 0; i < 2; ++i) { int R, C; stage_rc(tid * 16 + i * 8192, R, C); const int Rb = Epi::PERM ? ((R & ~31) + perm32(R & 31)) : R;
        voffA[i] = (unsigned)(R * K + C) * 2u; voffB[i] = (unsigned)(Rb * K + C) * 2u; }
    const size_t kstep = (size_t)(BK * 2);
    const size_t hstep = (size_t)HALF * K * 2;
    const size_t tstep = 2 * hstep;
    const unsigned ldsw = (unsigned)wid * 1024u;
    const int aoff = lds_byte(wr * 64 + fr, fq * 8), boff = lds_byte(wc * 32 + fr, fq * 8);
#define PG8_SA(b, h) (((b) * 2 + (h)) * HTB)
#define PG8_SB(b, h) ((4 + (b) * 2 + (h)) * HTB)
#define PG8_STAGE(bufoff, gbase, voff) do { _Pragma("unroll") for (int _i = 0; _i < 2; ++_i) \
        __builtin_amdgcn_global_load_lds((const unsigned*)((const char*)(gbase) + (voff)[_i]), (PG8_LAS unsigned*)(lds + (bufoff) + ldsw + _i * 8192), 16, 0, 0); } while (0)
#define PG8_LDA(dst, b, h) do { _Pragma("unroll") for (int m = 0; m < 4; ++m) _Pragma("unroll") for (int k = 0; k < 2; ++k) dst[m][k] = *(const PG8_LAS bf16x8*)(lds + PG8_SA(b, h) + aoff + m * 2048 + k * 1024); } while (0)
#define PG8_LDB(dst, b, h) do { _Pragma("unroll") for (int n = 0; n < 2; ++n) _Pragma("unroll") for (int k = 0; k < 2; ++k) dst[n][k] = *(const PG8_LAS bf16x8*)(lds + PG8_SB(b, h) + boff + n * 2048 + k * 1024); } while (0)
#define PG8_MMA(ai, bj, At, Bt) do { __builtin_amdgcn_s_setprio(1); _Pragma("unroll") for (int m = 0; m < 4; ++m) _Pragma("unroll") for (int n = 0; n < 2; ++n) _Pragma("unroll") for (int k = 0; k < 2; ++k) \
        acc[ai][bj][m][n] = __builtin_amdgcn_mfma_f32_16x16x32_bf16(Bt[n][k], At[m][k], acc[ai][bj][m][n], 0, 0, 0); __builtin_amdgcn_s_setprio(0); } while (0)
#define PG8_WAIT_V(n) asm volatile("s_waitcnt vmcnt(" #n ")" ::: "memory")
#define PG8_WAIT_L(n) asm volatile("s_waitcnt lgkmcnt(" #n ")" ::: "memory")
#define PG8_BAR __builtin_amdgcn_s_barrier()
#define PG8_SCHED __builtin_amdgcn_sched_barrier(0)
    Unit cur, nxt; int ui = 0;
    if (!S.next(0, cur)) return;
    f32x4 acc[2][2][4][2];
#pragma unroll
    for (int a = 0; a < 2; ++a)
#pragma unroll
        for (int b = 0; b < 2; ++b)
#pragma unroll
            for (int m = 0; m < 4; ++m)
#pragma unroll
                for (int n = 0; n < 2; ++n) acc[a][b][m][n] = (f32x4){0.f, 0.f, 0.f, 0.f};
    bf16x8 At[4][2], B0[2][2], B1[2][2];
    const char* cA = (const char*)g.A + (size_t)cur.pm * tstep; const char* cB = (const char*)g.Bt + (size_t)cur.pn * tstep;
    S.a_ready(cur);
    if constexpr (SP2) {
        PG8_STAGE(PG8_SB(0, 0), cB, voffB); PG8_STAGE(PG8_SB(0, 1), cB + hstep, voffB); PG8_STAGE(PG8_SA(0, 0), cA, voffA); PG8_STAGE(PG8_SA(0, 1), cA + hstep, voffA);
        if (wr == 1) PG8_BAR;
        PG8_WAIT_V(2); PG8_BAR;
        PG8_STAGE(PG8_SB(1, 0), cB + kstep, voffB); PG8_STAGE(PG8_SA(1, 0), cA + kstep, voffA); PG8_STAGE(PG8_SB(1, 1), cB + hstep + kstep, voffB);
        PG8_WAIT_V(6); PG8_BAR;
    } else {
        PG8_STAGE(PG8_SB(0, 0), cB, voffB); PG8_STAGE(PG8_SA(0, 0), cA, voffA); PG8_STAGE(PG8_SB(0, 1), cB + hstep, voffB); PG8_STAGE(PG8_SA(0, 1), cA + hstep, voffA);
        if (wr == 1) PG8_BAR;
        PG8_WAIT_V(4); PG8_BAR;
        PG8_STAGE(PG8_SB(1, 0), cB + kstep, voffB); PG8_STAGE(PG8_SA(1, 0), cA + kstep, voffA); PG8_STAGE(PG8_SB(1, 1), cB + hstep + kstep, voffB);
        PG8_WAIT_V(6); PG8_BAR;
    }
    for (;;) {
        const bool has_next = S.next(ui + 1, nxt);
        const char* nA = has_next ? (const char*)g.A + (size_t)nxt.pm * tstep : cA; const char* nB = has_next ? (const char*)g.Bt + (size_t)nxt.pn * tstep : cB;
        for (int t = 0; t < nt; t += 2) {
            const bool last = (t == nt - 2);
            const char* a1 = cA + (size_t)(t + 1) * kstep;
            const char* a2 = last ? nA : cA + (size_t)(t + 2) * kstep; const char* b2 = last ? nB : cB + (size_t)(t + 2) * kstep;
            const char* a3 = a2 + kstep; const char* b3 = b2 + kstep;
            if (last && has_next) S.a_ready(nxt);
            if constexpr (SP2) {
            PG8_LDB(B0, 0, 0); PG8_LDB(B1, 0, 1); PG8_SCHED; PG8_LDA(At, 0, 0); PG8_STAGE(PG8_SA(1, 1), a1 + hstep, voffA);
            PG8_WAIT_V(8); PG8_WAIT_L(0); PG8_BAR; PG8_MMA(0, 0, At, B0); PG8_MMA(0, 1, At, B1); PG8_BAR; PG8_SCHED;
            PG8_LDA(At, 0, 1); PG8_STAGE(PG8_SB(0, 0), b2, voffB); PG8_STAGE(PG8_SB(0, 1), b2 + hstep, voffB); PG8_STAGE(PG8_SA(0, 0), a2, voffA);
            PG8_WAIT_V(8); PG8_WAIT_L(0); PG8_BAR; PG8_MMA(1, 0, At, B0); PG8_MMA(1, 1, At, B1); PG8_BAR; PG8_SCHED;
            PG8_LDB(B0, 1, 0); PG8_LDB(B1, 1, 1); PG8_SCHED; PG8_LDA(At, 1, 0); PG8_STAGE(PG8_SA(0, 1), a2 + hstep, voffA);
            PG8_WAIT_V(8); PG8_WAIT_L(0); PG8_BAR; PG8_MMA(0, 0, At, B0); PG8_MMA(0, 1, At, B1); PG8_BAR; PG8_SCHED;
            PG8_LDA(At, 1, 1); PG8_STAGE(PG8_SB(1, 0), b3, voffB); PG8_STAGE(PG8_SB(1, 1), b3 + hstep, voffB); PG8_STAGE(PG8_SA(1, 0), a3, voffA);
            PG8_WAIT_V(8); PG8_WAIT_L(0); PG8_BAR; PG8_MMA(1, 0, At, B0); PG8_MMA(1, 1, At, B1); PG8_BAR; PG8_SCHED;
            } else {
            PG8_LDB(B0, 0, 0); PG8_SCHED; PG8_LDA(At, 0, 0); PG8_STAGE(PG8_SA(1, 1), a1 + hstep, voffA);
            PG8_WAIT_L(8); PG8_BAR; PG8_WAIT_L(0); PG8_MMA(0, 0, At, B0); PG8_BAR; PG8_SCHED;
            PG8_LDB(B1, 0, 1); PG8_STAGE(PG8_SB(0, 0), b2, voffB);
            PG8_BAR; PG8_WAIT_L(0); PG8_MMA(0, 1, At, B1); PG8_BAR;
            PG8_LDA(At, 0, 1); PG8_STAGE(PG8_SA(0, 0), a2, voffA);
            PG8_BAR; PG8_WAIT_L(0); PG8_MMA(1, 0, At, B0); PG8_BAR; PG8_SCHED;
            PG8_STAGE(PG8_SB(0, 1), b2 + hstep, voffB);
            PG8_WAIT_V(6); PG8_BAR; PG8_MMA(1, 1, At, B1); PG8_BAR;
            PG8_LDB(B0, 1, 0); PG8_SCHED; PG8_LDA(At, 1, 0); PG8_STAGE(PG8_SA(0, 1), a2 + hstep, voffA);
            PG8_WAIT_L(8); PG8_BAR; PG8_WAIT_L(0); PG8_MMA(0, 0, At, B0); PG8_BAR; PG8_SCHED;
            PG8_LDB(B1, 1, 1); PG8_STAGE(PG8_SB(1, 0), b3, voffB);
            PG8_BAR; PG8_WAIT_L(0); PG8_MMA(0, 1, At, B1); PG8_BAR;
            PG8_LDA(At, 1, 1); PG8_STAGE(PG8_SA(1, 0), a3, voffA);
            PG8_BAR; PG8_WAIT_L(0); PG8_MMA(1, 0, At, B0); PG8_BAR; PG8_SCHED;
            PG8_STAGE(PG8_SB(1, 1), b3 + hstep, voffB);
            PG8_WAIT_V(6); PG8_BAR; PG8_MMA(1, 1, At, B1); PG8_BAR;
            }
        }
        if constexpr (ALIGN_EPI) { if (wr == 0) PG8_BAR; }
        if constexpr (!Epi::AFTER_DRAIN) { E(acc, cur, wr, wc, fr, fq); S.done(cur); }
        if (!has_next) break;
#pragma unroll
        for (int a = 0; a < 2; ++a)
#pragma unroll
            for (int b = 0; b < 2; ++b)
#pragma unroll
                for (int m = 0; m < 4; ++m)
#pragma unroll
                    for (int n = 0; n < 2; ++n) acc[a][b][m][n] = (f32x4){0.f, 0.f, 0.f, 0.f};
        cur = nxt; cA = nA; cB = nB; ++ui;
        if constexpr (ALIGN_EPI) { if (wr == 1) PG8_BAR; }
    }
    PG8_WAIT_V(0);
    if constexpr (!ALIGN_EPI) { if (wr == 0) PG8_BAR; }
    PG8_BAR;
    if constexpr (Epi::AFTER_DRAIN) { E.fused(acc, cur, wr, wc, fr, fq, lds, wid, lane); S.done(cur); }
#undef PG8_SA
#undef PG8_SB
#undef PG8_STAGE
#undef PG8_LDA
#undef PG8_LDB
#undef PG8_MMA
#undef PG8_WAIT_V
#undef PG8_WAIT_L
#undef PG8_BAR
#undef PG8_SCHED
}
}

constexpr int NWAVES = 8, NT = 512;
constexpr int SEQ = 16384, M = 32768, D = 2048, NIN = 6144, NINP = 6400, NIN_SRC = 6160, DFF = 5632, NUP = 11264, MH = 16384;
constexpr int C_CB = 0, C_CC = 1024, C_CX = 2048, C_Q = 3072, C_K = 3584, C_V = 4096, C_R = 5120;
constexpr float EPS = 1e-6f;
constexpr size_t MiB = 1u << 20;
constexpr size_t WS_MOD = 1 * MiB;
constexpr size_t WS_WIN = 2 * MiB, WS_WOUT = 27 * MiB, WS_WUP = 35 * MiB, WS_WDN = 79 * MiB;
constexpr size_t WS_H = 104 * MiB;
constexpr size_t WS_PROJ = 232 * MiB;
constexpr size_t WS_ALR = 616 * MiB;
constexpr size_t WS_S = 618 * MiB;
constexpr size_t WS_DEC = 746 * MiB;
constexpr size_t WS_Y = 748 * MiB;
constexpr size_t WS_HALO = 232 * MiB;
constexpr size_t WS_ACT = 584 * MiB;
constexpr size_t WS_Y2 = 232 * MiB;
constexpr size_t WS_END = 936 * MiB;
constexpr int LDS_BYTES = 147456;

#define GAS __attribute__((address_space(1)))
#define LAS __attribute__((address_space(3)))
typedef unsigned short bf16;
typedef unsigned v4u __attribute__((ext_vector_type(4)));
typedef unsigned v2u __attribute__((ext_vector_type(2)));
typedef float f32x4 __attribute__((ext_vector_type(4)));
typedef float f32x2 __attribute__((ext_vector_type(2)));
typedef short bf16x8 __attribute__((ext_vector_type(8)));
#define LDS_WAIT() asm volatile("s_waitcnt lgkmcnt(0)" ::: "memory")

__device__ __forceinline__ unsigned pk2(float lo, float hi) { return pg8::cvt_pk_bf16_safe(lo, hi); }
__device__ __forceinline__ float bflo(unsigned w) { return __uint_as_float(w << 16); }
__device__ __forceinline__ float bfhi(unsigned w) { return __uint_as_float(w & 0xffff0000u); }
__device__ __forceinline__ float bf1(bf16 b) { return __uint_as_float(((unsigned)b) << 16); }
__device__ __forceinline__ float silu_f(float v) { return v / (1.0f + __expf(-v)); }
__device__ __forceinline__ float wave_sum(float v) {
#pragma unroll
    for (int o = 1; o < 64; o <<= 1) v += __shfl_xor(v, o);
    return v;
}
__device__ __forceinline__ void unpack8(const v4u w, float (&f)[8]) {
    f[0] = bflo(w.x); f[1] = bfhi(w.x); f[2] = bflo(w.y); f[3] = bfhi(w.y); f[4] = bflo(w.z); f[5] = bfhi(w.z); f[6] = bflo(w.w); f[7] = bfhi(w.w);
}
__device__ __forceinline__ v4u pack8(const float (&f)[8]) { v4u w; w.x = pk2(f[0], f[1]); w.y = pk2(f[2], f[3]); w.z = pk2(f[4], f[5]); w.w = pk2(f[6], f[7]); return w; }

struct Args { const float* in[17]; float* out; unsigned char* ws; int ph_lo, ph_hi; };
enum { I_X = 0, I_C, I_WMOD, I_BMOD, I_MIXPRE, I_MIXPOST, I_WIN, I_CONVW, I_GW2, I_GB, I_GNW, I_WOUT, I_FPRE, I_FPOST, I_WUP, I_FCONVW, I_WDN };

__device__ __forceinline__ void transpose_item(const float* W, int K, int N, int k0, int n0, int ncols, bf16* WT, int drow0, LAS float* scr, int lane) {
    const int c4 = lane & 7, kr = lane >> 3; const bool cv = 4 * c4 < ncols;
    f32x4 wl[8];
#pragma unroll
    for (int i = 0; i < 8; ++i) wl[i] = cv ? *(const f32x4*)(W + (size_t)(k0 + 8 * i + kr) * N + n0 + 4 * c4) : (f32x4){0.f, 0.f, 0.f, 0.f};
#pragma unroll
    for (int i = 0; i < 8; ++i) { LAS float* sp = scr + (8 * i + kr) * 33 + 4 * c4; sp[0] = wl[i].x; sp[1] = wl[i].y; sp[2] = wl[i].z; sp[3] = wl[i].w; }
    LDS_WAIT(); asm volatile("" ::: "memory");
    const int c = lane & 7;
#pragma unroll
    for (int j = 0; j < 4; ++j) { const int n = (lane >> 3) + 8 * j; const LAS float* s = scr + (8 * c) * 33 + n;
        v4u o; o.x = pk2(s[0 * 33], s[1 * 33]); o.y = pk2(s[2 * 33], s[3 * 33]); o.z = pk2(s[4 * 33], s[5 * 33]); o.w = pk2(s[6 * 33], s[7 * 33]);
        if (n < ncols) *(v4u*)(WT + (size_t)(drow0 + n) * K + k0 + 8 * c) = o; }
    LDS_WAIT(); asm volatile("" ::: "memory");
}

__device__ __forceinline__ void phase_prologue(const Args& a, LAS unsigned char* lds, int tid, int lane, int wave) {
    unsigned char* ws = a.ws;
    if (blockIdx.x < 192) {
        LAS float* ca = (LAS float*)lds;
        LAS float* red = (LAS float*)(lds + 16384);
        const float* c = a.in[I_C];
        for (int i = tid; i < 4096; i += NT) ca[i] = silu_f(c[i]);
        __syncthreads();
        const int col = blockIdx.x * 64 + lane; const float* wm = a.in[I_WMOD] + col;
        float a0 = 0.f, a1 = 0.f;
        for (int k0 = wave * 256; k0 < wave * 256 + 256; k0 += 32) {
            float wv[32];
#pragma unroll
            for (int i = 0; i < 32; ++i) wv[i] = wm[(size_t)(k0 + i) * 12288];
#pragma unroll
            for (int i = 0; i < 32; ++i) { a0 += ca[k0 + i] * wv[i]; a1 += ca[2048 + k0 + i] * wv[i]; } }
        red[(wave * 2 + 0) * 64 + lane] = a0; red[(wave * 2 + 1) * 64 + lane] = a1;
        __syncthreads();
        if (tid < 128) { const int b = tid >> 6, l = tid & 63; float s = 0.f;
#pragma unroll
            for (int w = 0; w < 8; ++w) s += red[(w * 2 + b) * 64 + l];
            const int cc = blockIdx.x * 64 + l; ((float*)(ws + WS_MOD))[b * 12288 + cc] = s + a.in[I_BMOD][cc]; }
        __syncthreads();
    }
    LAS float* scr = (LAS float*)(lds + wave * 16384);
    const int gw = blockIdx.x * NWAVES + wave, NGW = gridDim.x * NWAVES;
    constexpr int IT_IN = 32 * 193, IT_OUT = 32 * 64, IT_UP = 32 * 352, IT_DN = 88 * 64;
    for (int it = gw; it < IT_IN + IT_OUT + IT_UP + IT_DN; it += NGW) {
        int r = it;
        if (r < IT_IN) { const int kb = r / 193, nb = r % 193; transpose_item(a.in[I_WIN], D, NIN_SRC, 64 * kb, 32 * nb, nb == 192 ? 16 : 32, (bf16*)(ws + WS_WIN), 32 * nb, scr, lane); continue; } r -= IT_IN;
        if (r < IT_OUT) { const int kb = r / 64, nb = r % 64; transpose_item(a.in[I_WOUT], D, D, 64 * kb, 32 * nb, 32, (bf16*)(ws + WS_WOUT), 32 * nb, scr, lane); continue; } r -= IT_OUT;
        if (r < IT_UP) { const int kb = r / 352, nb = r % 352; const int n0 = 32 * nb; const int jj = n0 < DFF ? n0 : n0 - DFF;
            const int drow = 256 * (jj >> 7) + (n0 < DFF ? 0 : 128) + (jj & 127);
            transpose_item(a.in[I_WUP], D, NUP, 64 * kb, n0, 32, (bf16*)(ws + WS_WUP), drow, scr, lane); continue; } r -= IT_UP;
        { const int kb = r / 64, nb = r % 64; transpose_item(a.in[I_WDN], DFF, D, 64 * kb, 32 * nb, 32, (bf16*)(ws + WS_WDN), 32 * nb, scr, lane); }
    }
}

__device__ __forceinline__ void phase_h1(const Args& a, int lane, int wave) {
    const float* mod = (const float*)(a.ws + WS_MOD); bf16* H = (bf16*)(a.ws + WS_H);
    const int NGW = gridDim.x * NWAVES;
    for (int rb = blockIdx.x * NWAVES + wave; rb < M / 16; rb += NGW) {
        const int m0 = rb * 16, b = m0 >> 14; const float* mb = mod + b * 12288;
        float A[4][8], B[4][8];
#pragma unroll
        for (int j = 0; j < 4; ++j)
#pragma unroll
            for (int e = 0; e < 8; ++e) { const int col = 512 * j + 8 * lane + e; A[j][e] = a.in[I_MIXPRE][col] * (1.0f + mb[2048 + col]); B[j][e] = mb[col]; }
        for (int r = 0; r < 16; ++r) {
            const float* xr = a.in[I_X] + (size_t)(m0 + r) * D + 8 * lane;
            f32x4 v[4][2]; float ss = 0.f;
#pragma unroll
            for (int j = 0; j < 4; ++j) { v[j][0] = *(const f32x4*)(xr + 512 * j); v[j][1] = *(const f32x4*)(xr + 512 * j + 4); }
#pragma unroll
            for (int j = 0; j < 4; ++j)
#pragma unroll
                for (int q = 0; q < 2; ++q) ss += (v[j][q].x * v[j][q].x + v[j][q].y * v[j][q].y) + (v[j][q].z * v[j][q].z + v[j][q].w * v[j][q].w);
            const float rstd = rsqrtf(wave_sum(ss) * (1.0f / D) + EPS);
            bf16* hr = H + (size_t)(m0 + r) * D + 8 * lane;
#pragma unroll
            for (int j = 0; j < 4; ++j) { float o[8];
#pragma unroll
                for (int e = 0; e < 8; ++e) o[e] = v[j][e >> 2][e & 3] * rstd * A[j][e] + B[j][e];
                *(v4u*)(hr + 512 * j) = pack8(o); }
        }
        asm volatile("s_waitcnt vmcnt(0)" ::: "memory");
        { const int r16 = lane & 15, q4 = lane >> 4;
          const bf16* hrow = H + (size_t)(m0 + r16) * D + 8 * q4; const bf16* wrow = (const bf16*)(a.ws + WS_WIN) + (size_t)(NIN + r16) * D + 8 * q4;
          f32x4 acc0 = (f32x4){0.f, 0.f, 0.f, 0.f}, acc1 = acc0;
#pragma unroll 4
          for (int ks = 0; ks < 64; ks += 2) {
              const bf16x8 a0 = *(const bf16x8*)(hrow + 32 * ks), b0 = *(const bf16x8*)(wrow + 32 * ks), a1 = *(const bf16x8*)(hrow + 32 * ks + 32), b1 = *(const bf16x8*)(wrow + 32 * ks + 32);
              acc0 = __builtin_amdgcn_mfma_f32_16x16x32_bf16(a0, b0, acc0, 0, 0, 0); acc1 = __builtin_amdgcn_mfma_f32_16x16x32_bf16(a1, b1, acc1, 0, 0, 0); }
          float* alr = (float*)(a.ws + WS_ALR);
#pragma unroll
          for (int x = 0; x < 4; ++x) alr[(size_t)(m0 + 4 * q4 + x) * 16 + r16] = acc0[x] + acc1[x]; }
    }
}

struct GateIn { f32x4 av; float w2r[16]; float gb; };
__device__ __forceinline__ void gates_load(const Args& a, int m0, int h, int tid, GateIn& g) {
    const float* alr = (const float*)(a.ws + WS_ALR) + (size_t)m0 * 16;
    g.av = (f32x4){0.f, 0.f, 0.f, 0.f};
    if (tid < 256) g.av = *(const f32x4*)(alr + 4 * tid);
    const int d = tid & 127;
#pragma unroll
    for (int r = 0; r < 16; ++r) g.w2r[r] = a.in[I_GW2][r * 512 + h * 128 + d];
    g.gb = a.in[I_GB][h * 128 + d];
}
__device__ __forceinline__ void gates_compute(const GateIn& g, LAS float* aL, LAS float* tot, int tid, float (&bq)[16], float& blast) {
    if (tid < 256) *(LAS f32x4*)(aL + 4 * tid) = g.av;
    const int d = tid & 127, ig = tid >> 7;
    __syncthreads();
    float run = 0.f;
#pragma unroll
    for (int ii = 0; ii < 16; ++ii) { const LAS f32x4* ar = (const LAS f32x4*)(aL + (16 * ig + ii) * 16); float z = g.gb;
#pragma unroll
        for (int r4 = 0; r4 < 4; ++r4) { const f32x4 av = ar[r4]; z += av.x * g.w2r[4 * r4] + av.y * g.w2r[4 * r4 + 1] + av.z * g.w2r[4 * r4 + 2] + av.w * g.w2r[4 * r4 + 3]; }
        const float ls = fminf(z, 0.f) - __logf(1.0f + __expf(-fabsf(z)));
        run += ls * (1.0f / 16.0f); bq[ii] = run; }
    tot[ig * 128 + d] = run;
    __syncthreads();
    float off = 0.f, all = 0.f;
#pragma unroll
    for (int gg = 0; gg < 4; ++gg) { const float t = tot[gg * 128 + d]; all += t; off += (gg < ig) ? t : 0.f; }
#pragma unroll
    for (int ii = 0; ii < 16; ++ii) bq[ii] += off;
    blast = all;
}

__device__ __forceinline__ void phase_g1(const Args& a, LAS unsigned char* lds, int tid, int lane, int wave) {
    LAS float* aL = (LAS float*)lds; LAS float* tot = (LAS float*)(lds + 4096); LAS bf16* kdT = (LAS bf16*)(lds + 8192);
    LAS bf16* Kr = (LAS bf16*)(lds + 26624); LAS bf16* Vs = (LAS bf16*)(lds + 44032);
    const bf16* proj = (const bf16*)(a.ws + WS_PROJ); bf16* S = (bf16*)(a.ws + WS_S); float* dec = (float*)(a.ws + WS_DEC);
    const int d = tid & 127, ig = tid >> 7, r16 = lane & 15, q4 = lane >> 4;
    for (int unit = blockIdx.x; unit < 2048; unit += gridDim.x) {
        const int bh = unit >> 8, n = unit & 255, b = bh >> 2, h = bh & 3, m0 = b * SEQ + n * 64;
        float bq[16], blast;
        GateIn gin; gates_load(a, m0, h, tid, gin);
        v4u kreg[2], vreg[4];
#pragma unroll
        for (int s2 = 0; s2 < 2; ++s2) { const int c = tid + 512 * s2; kreg[s2] = *(const v4u*)(proj + (size_t)(m0 + (c >> 4)) * NIN + C_K + h * 128 + 8 * (c & 15)); }
#pragma unroll
        for (int s4 = 0; s4 < 4; ++s4) { const int c = tid + 512 * s4; vreg[s4] = *(const v4u*)(proj + (size_t)(m0 + (c >> 5)) * NIN + C_V + h * 256 + 8 * (c & 31)); }
        gates_compute(gin, aL, tot, tid, bq, blast);
#pragma unroll
        for (int s2 = 0; s2 < 2; ++s2) { const int c = tid + 512 * s2; *(LAS v4u*)(Kr + (c >> 4) * 136 + 8 * (c & 15)) = kreg[s2]; }
#pragma unroll
        for (int s4 = 0; s4 < 4; ++s4) { const int c = tid + 512 * s4; *(LAS v4u*)(Vs + (c >> 5) * 264 + 8 * (c & 31)) = vreg[s4]; }
        __syncthreads();
        { float kd[16];
#pragma unroll
          for (int ii = 0; ii < 16; ++ii) kd[ii] = bf1(Kr[(16 * ig + ii) * 136 + d]) * __expf(blast - bq[ii]);
          v4u w0, w1; w0.x = pk2(kd[0], kd[1]); w0.y = pk2(kd[2], kd[3]); w0.z = pk2(kd[4], kd[5]); w0.w = pk2(kd[6], kd[7]);
          w1.x = pk2(kd[8], kd[9]); w1.y = pk2(kd[10], kd[11]); w1.z = pk2(kd[12], kd[13]); w1.w = pk2(kd[14], kd[15]);
          *(LAS v4u*)(kdT + d * 72 + 16 * ig) = w0; *(LAS v4u*)(kdT + d * 72 + 16 * ig + 8) = w1;
          if (ig == 0) dec[unit * 128 + d] = __expf(blast); }
        bf16x8 vf[2][2];
#pragma unroll
        for (int nt = 0; nt < 2; ++nt)
#pragma unroll
            for (int ks = 0; ks < 2; ++ks)
#pragma unroll
                for (int jj = 0; jj < 8; ++jj) vf[nt][ks][jj] = (short)Vs[(32 * ks + 8 * q4 + jj) * 264 + 32 * wave + 16 * nt + r16];
        __syncthreads();
        f32x4 acc[8][2];
#pragma unroll
        for (int mt = 0; mt < 8; ++mt)
#pragma unroll
            for (int nt = 0; nt < 2; ++nt) acc[mt][nt] = (f32x4){0.f, 0.f, 0.f, 0.f};
#pragma unroll
        for (int mt = 0; mt < 8; ++mt)
#pragma unroll
            for (int ks = 0; ks < 2; ++ks) { const bf16x8 af = *(const LAS bf16x8*)(kdT + (16 * mt + r16) * 72 + 32 * ks + 8 * q4);
#pragma unroll
                for (int nt = 0; nt < 2; ++nt) acc[mt][nt] = __builtin_amdgcn_mfma_f32_16x16x32_bf16(af, vf[nt][ks], acc[mt][nt], 0, 0, 0); }
        bf16* Su = S + (size_t)unit * 32768;
#pragma unroll
        for (int mt = 0; mt < 8; ++mt)
#pragma unroll
            for (int nt = 0; nt < 2; ++nt) { v2u w; w.x = pk2(acc[mt][nt][0], acc[mt][nt][1]); w.y = pk2(acc[mt][nt][2], acc[mt][nt][3]);
                *(v2u*)(Su + (32 * wave + 16 * nt + r16) * 128 + 16 * mt + 4 * q4) = w; }
        __syncthreads();
    }
    bf16* Y = (bf16*)(a.ws + WS_H);
    for (int item = blockIdx.x; item < M / 64; item += gridDim.x) {
        const int c0 = 8 * (tid & 127), mr = item * 64 + 16 * (tid >> 7);
        float w0[8], w1[8], w2[8], p1[8], p2[8];
#pragma unroll
        for (int e = 0; e < 8; ++e) { w0[e] = a.in[I_CONVW][c0 + e]; w1[e] = a.in[I_CONVW][1024 + c0 + e]; w2[e] = a.in[I_CONVW][2048 + c0 + e]; p1[e] = 0.f; p2[e] = 0.f; }
        if ((mr & (SEQ - 1)) != 0) {
            float c1[8], x1[8]; const bf16* r2 = proj + (size_t)(mr - 2) * NIN + c0; const bf16* r1 = proj + (size_t)(mr - 1) * NIN + c0;
            unpack8(*(const v4u*)(r2 + C_CC), c1); unpack8(*(const v4u*)(r2 + C_CX), x1);
#pragma unroll
            for (int e = 0; e < 8; ++e) p2[e] = c1[e] * x1[e];
            unpack8(*(const v4u*)(r1 + C_CC), c1); unpack8(*(const v4u*)(r1 + C_CX), x1);
#pragma unroll
            for (int e = 0; e < 8; ++e) p1[e] = c1[e] * x1[e];
        }
        for (int r0 = 0; r0 < 16; r0 += 4) {
            v4u rb[4], rc[4], rx[4];
#pragma unroll
            for (int q = 0; q < 4; ++q) { const bf16* rp = proj + (size_t)(mr + r0 + q) * NIN + c0; rb[q] = *(const v4u*)(rp + C_CB); rc[q] = *(const v4u*)(rp + C_CC); rx[q] = *(const v4u*)(rp + C_CX); }
#pragma unroll
            for (int q = 0; q < 4; ++q) { float cb[8], cc[8], cx[8], o[8];
                unpack8(rb[q], cb); unpack8(rc[q], cc); unpack8(rx[q], cx);
#pragma unroll
                for (int e = 0; e < 8; ++e) { const float p0 = cc[e] * cx[e]; o[e] = cb[e] * (w0[e] * p2[e] + w1[e] * p1[e] + w2[e] * p0); p2[e] = p1[e]; p1[e] = p0; }
                *(v4u*)(Y + (size_t)(mr + r0 + q) * D + c0) = pack8(o); }
        }
    }
}

__device__ __forceinline__ void phase_g2(const Args& a, int tid) {
    unsigned* S = (unsigned*)(a.ws + WS_S); const float* dec = (const float*)(a.ws + WS_DEC);
    const int total = gridDim.x * NT;
    for (int idx = blockIdx.x * NT + tid; idx < 8 * 16384; idx += total) {
        const int bh = idx >> 14, r = idx & 16383, d0 = (2 * r) & 127;
        float s0 = 0.f, s1 = 0.f;
        for (int n0 = 0; n0 < 256; n0 += 16) {
            unsigned w[16]; f32x2 dd[16];
#pragma unroll
            for (int i = 0; i < 16; ++i) { const int unit = bh * 256 + n0 + i; w[i] = S[(size_t)unit * 16384 + r]; dd[i] = *(const f32x2*)(dec + unit * 128 + d0); }
#pragma unroll
            for (int i = 0; i < 16; ++i) { const int unit = bh * 256 + n0 + i; S[(size_t)unit * 16384 + r] = pk2(s0, s1);
                s0 = dd[i].x * s0 + bflo(w[i]); s1 = dd[i].y * s1 + bfhi(w[i]); }
        }
    }
}

__device__ __forceinline__ void phase_g3(const Args& a, LAS unsigned char* lds, int tid, int lane, int wave) {
    LAS float* aL = (LAS float*)lds; LAS float* tot = (LAS float*)(lds + 4096); LAS float* part = (LAS float*)(lds + 6144); LAS float* rstdL = (LAS float*)(lds + 8192);
    LAS bf16* Qs = (LAS bf16*)(lds + 8704); LAS bf16* Ks = (LAS bf16*)(lds + 8704 + 17408); LAS bf16* Ps = (LAS bf16*)(lds + 8704 + 2 * 17408);
    LAS bf16* Vs = (LAS bf16*)(lds + 52736); LAS bf16* Rs = (LAS bf16*)(lds + 86528);
    const bf16* proj = (const bf16*)(a.ws + WS_PROJ); const bf16* S = (const bf16*)(a.ws + WS_S); bf16* Y = (bf16*)(a.ws + WS_H);
    const int d = tid & 127, ig = tid >> 7, r16 = lane & 15, q4 = lane >> 4;
    for (int unit = blockIdx.x; unit < 2048; unit += gridDim.x) {
        const int bh = unit >> 8, n = unit & 255, b = bh >> 2, h = bh & 3, m0 = b * SEQ + n * 64;
        float bq[16], blast;
        GateIn gin; gates_load(a, m0, h, tid, gin);
        v4u qreg[2], kreg[2], vreg[4], rreg[4];
#pragma unroll
        for (int s2 = 0; s2 < 2; ++s2) { const int c = tid + 512 * s2; const bf16* rp = proj + (size_t)(m0 + (c >> 4)) * NIN + h * 128 + 8 * (c & 15); qreg[s2] = *(const v4u*)(rp + C_Q); kreg[s2] = *(const v4u*)(rp + C_K); }
#pragma unroll
        for (int s4 = 0; s4 < 4; ++s4) { const int c = tid + 512 * s4; const bf16* rp = proj + (size_t)(m0 + (c >> 5)) * NIN + h * 256 + 8 * (c & 31); vreg[s4] = *(const v4u*)(rp + C_V); rreg[s4] = *(const v4u*)(rp + C_R); }
        const bf16* Su = S + (size_t)unit * 32768;
        bf16x8 sf[4][2];
#pragma unroll
        for (int ks = 0; ks < 4; ++ks)
#pragma unroll
            for (int nt = 0; nt < 2; ++nt) sf[ks][nt] = *(const bf16x8*)(Su + (32 * wave + 16 * nt + r16) * 128 + 32 * ks + 8 * q4);
        gates_compute(gin, aL, tot, tid, bq, blast);
#pragma unroll
        for (int s2 = 0; s2 < 2; ++s2) { const int c = tid + 512 * s2; *(LAS v4u*)(Qs + (c >> 4) * 136 + 8 * (c & 15)) = qreg[s2]; *(LAS v4u*)(Ks + (c >> 4) * 136 + 8 * (c & 15)) = kreg[s2]; }
#pragma unroll
        for (int s4 = 0; s4 < 4; ++s4) { const int c = tid + 512 * s4; *(LAS v4u*)(Vs + (c >> 5) * 264 + 8 * (c & 31)) = vreg[s4]; *(LAS v4u*)(Rs + (c >> 5) * 264 + 8 * (c & 31)) = rreg[s4]; }
        __syncthreads();
#pragma unroll
        for (int ii = 0; ii < 16; ++ii) { const int i = 16 * ig + ii;
            const float qv = bf1(Qs[i * 136 + d]), kv = bf1(Ks[i * 136 + d]);
            Qs[i * 136 + d] = (bf16)(pk2(qv * 0.08838834764831845f * __expf(bq[ii]), 0.f) & 0xffffu);
            Ks[i * 136 + d] = (bf16)(pk2(kv * __expf(-bq[ii]), 0.f) & 0xffffu); }
        bf16x8 vf[2][2];
#pragma unroll
        for (int nt = 0; nt < 2; ++nt)
#pragma unroll
            for (int ks = 0; ks < 2; ++ks)
#pragma unroll
                for (int jj = 0; jj < 8; ++jj) vf[nt][ks][jj] = (short)Vs[(32 * ks + 8 * q4 + jj) * 264 + 32 * wave + 16 * nt + r16];
        __syncthreads();
#pragma unroll
        for (int tt = 0; tt < 2; ++tt) { const int t = 2 * wave + tt, it = t >> 2, jt = t & 3;
            f32x4 sc = (f32x4){0.f, 0.f, 0.f, 0.f};
            if (jt <= it) {
#pragma unroll
                for (int ks = 0; ks < 4; ++ks) { const bf16x8 af = *(const LAS bf16x8*)(Qs + (16 * it + r16) * 136 + 32 * ks + 8 * q4); const bf16x8 bf = *(const LAS bf16x8*)(Ks + (16 * jt + r16) * 136 + 32 * ks + 8 * q4);
                    sc = __builtin_amdgcn_mfma_f32_16x16x32_bf16(af, bf, sc, 0, 0, 0); } }
#pragma unroll
            for (int x = 0; x < 4; ++x) { const int i = 16 * it + 4 * q4 + x, j = 16 * jt + r16; Ps[i * 72 + j] = (bf16)(pk2(j <= i ? sc[x] : 0.f, 0.f) & 0xffffu); } }
        __syncthreads();
        f32x4 acc[4][2];
#pragma unroll
        for (int mt = 0; mt < 4; ++mt)
#pragma unroll
            for (int nt = 0; nt < 2; ++nt) acc[mt][nt] = (f32x4){0.f, 0.f, 0.f, 0.f};
#pragma unroll
        for (int ks = 0; ks < 2; ++ks)
#pragma unroll
            for (int mt = 0; mt < 4; ++mt) { const bf16x8 af = *(const LAS bf16x8*)(Ps + (16 * mt + r16) * 72 + 32 * ks + 8 * q4);
#pragma unroll
                for (int nt = 0; nt < 2; ++nt) acc[mt][nt] = __builtin_amdgcn_mfma_f32_16x16x32_bf16(af, vf[nt][ks], acc[mt][nt], 0, 0, 0); }
#pragma unroll
        for (int ks = 0; ks < 4; ++ks) {
#pragma unroll
            for (int mt = 0; mt < 4; ++mt) { const bf16x8 af = *(const LAS bf16x8*)(Qs + (16 * mt + r16) * 136 + 32 * ks + 8 * q4);
#pragma unroll
                for (int nt = 0; nt < 2; ++nt) acc[mt][nt] = __builtin_amdgcn_mfma_f32_16x16x32_bf16(af, sf[ks][nt], acc[mt][nt], 0, 0, 0); } }
#pragma unroll
        for (int mt = 0; mt < 4; ++mt)
#pragma unroll
            for (int x = 0; x < 4; ++x) { float ss = acc[mt][0][x] * acc[mt][0][x] + acc[mt][1][x] * acc[mt][1][x];
                ss += __shfl_xor(ss, 1); ss += __shfl_xor(ss, 2); ss += __shfl_xor(ss, 4); ss += __shfl_xor(ss, 8);
                if (r16 == 0) part[wave * 64 + 16 * mt + 4 * q4 + x] = ss; }
        __syncthreads();
        if (tid < 64) { float s = 0.f;
#pragma unroll
            for (int w = 0; w < 8; ++w) s += part[w * 64 + tid];
            rstdL[tid] = rsqrtf(s * (1.0f / 256.0f) + EPS); }
        __syncthreads();
#pragma unroll
        for (int nt = 0; nt < 2; ++nt) { const int e = 32 * wave + 16 * nt + r16; const float gw = a.in[I_GNW][e];
#pragma unroll
            for (int mt = 0; mt < 4; ++mt)
#pragma unroll
                for (int x = 0; x < 4; ++x) { const int i = 16 * mt + 4 * q4 + x; const float rr = bf1(Rs[i * 264 + e]);
                    const float y = acc[mt][nt][x] * rstdL[i] * gw * silu_f(rr);
                    Rs[i * 264 + e] = (bf16)(pk2(y, 0.f) & 0xffffu); } }
        __syncthreads();
#pragma unroll
        for (int s4 = 0; s4 < 4; ++s4) { const int c = tid + 512 * s4; *(v4u*)(Y + (size_t)(m0 + (c >> 5)) * D + 1024 + h * 256 + 8 * (c & 31)) = *(const LAS v4u*)(Rs + (c >> 5) * 264 + 8 * (c & 31)); }
        __syncthreads();
    }
}

__device__ __forceinline__ void phase_mid(const Args& a, int lane, int wave) {
    const float* mod = (const float*)(a.ws + WS_MOD); bf16* H = (bf16*)(a.ws + WS_H); const bf16* Yb = (const bf16*)(a.ws + WS_Y);
    const int NGW = gridDim.x * NWAVES;
    for (int rb = blockIdx.x * NWAVES + wave; rb < M / 16; rb += NGW) {
        const int m0 = rb * 16, b = m0 >> 14; const float* mb = mod + b * 12288;
        float G[4][8], A[4][8], B[4][8];
#pragma unroll
        for (int j = 0; j < 4; ++j)
#pragma unroll
            for (int e = 0; e < 8; ++e) { const int col = 512 * j + 8 * lane + e; G[j][e] = mb[4096 + col] * a.in[I_MIXPOST][col];
                A[j][e] = a.in[I_FPRE][col] * (1.0f + mb[8192 + col]); B[j][e] = mb[6144 + col]; }
        for (int r = 0; r < 16; ++r) {
            const size_t ro = (size_t)(m0 + r) * D + 8 * lane;
            float y[4][8]; float ss = 0.f;
#pragma unroll
            for (int j = 0; j < 4; ++j) { unpack8(*(const v4u*)(Yb + ro + 512 * j), y[j]);
#pragma unroll
                for (int e = 0; e < 8; ++e) ss += y[j][e] * y[j][e]; }
            const float rstd = rsqrtf(wave_sum(ss) * (1.0f / D) + EPS);
            float s2 = 0.f;
#pragma unroll
            for (int j = 0; j < 4; ++j) { const f32x4 xa = *(const f32x4*)(a.in[I_X] + ro + 512 * j), xb = *(const f32x4*)(a.in[I_X] + ro + 512 * j + 4);
#pragma unroll
                for (int e = 0; e < 8; ++e) { const float xv = (e < 4 ? xa[e & 3] : xb[e & 3]) + G[j][e] * (y[j][e] * rstd); y[j][e] = xv; s2 += xv * xv; }
                *(f32x4*)(a.out + ro + 512 * j) = (f32x4){y[j][0], y[j][1], y[j][2], y[j][3]}; *(f32x4*)(a.out + ro + 512 * j + 4) = (f32x4){y[j][4], y[j][5], y[j][6], y[j][7]}; }
            const float rstd2 = rsqrtf(wave_sum(s2) * (1.0f / D) + EPS);
#pragma unroll
            for (int j = 0; j < 4; ++j) { float o[8];
#pragma unroll
                for (int e = 0; e < 8; ++e) o[e] = y[j][e] * rstd2 * A[j][e] + B[j][e];
                *(v4u*)(H + ro + 512 * j) = pack8(o); }
        }
    }
}

__device__ __forceinline__ void phase_fixup(const Args& a, int tid) {
    const bf16* HALO = (const bf16*)(a.ws + WS_HALO); bf16* ACT = (bf16*)(a.ws + WS_ACT); const float* cw = a.in[I_FCONVW];
    const int total = gridDim.x * NT;
    for (int item = blockIdx.x * NT + tid; item < 512 * 2 * 704; item += total) {
        const int cg = item % 704, gl = item / 704, lr = gl & 1, G = gl >> 1, j0 = 8 * cg, uc = 256 * (j0 >> 7) + (j0 & 127);
        const bool first = (G & 255) == 0;
        const bf16* hc = HALO + ((size_t)G * 4 + lr) * NUP + uc;
        const bf16* h1 = lr == 0 ? HALO + ((size_t)(G - 1) * 4 + 3) * NUP + uc : HALO + ((size_t)G * 4 + 0) * NUP + uc;
        const bf16* h2 = lr == 0 ? HALO + ((size_t)(G - 1) * 4 + 2) * NUP + uc : HALO + ((size_t)(G - 1) * 4 + 3) * NUP + uc;
        float g0[8], v0[8], g1[8], v1[8], g2[8], v2[8], o[8];
        unpack8(*(const v4u*)hc, g0); unpack8(*(const v4u*)(hc + 128), v0);
#pragma unroll
        for (int e = 0; e < 8; ++e) { g1[e] = 0.f; v1[e] = 0.f; g2[e] = 0.f; v2[e] = 0.f; }
        if (!(first && lr == 0)) { unpack8(*(const v4u*)h1, g1); unpack8(*(const v4u*)(h1 + 128), v1); }
        if (!first) { unpack8(*(const v4u*)h2, g2); unpack8(*(const v4u*)(h2 + 128), v2); }
#pragma unroll
        for (int e = 0; e < 8; ++e) { const float gg = cw[j0 + e] * g2[e] + cw[NUP + j0 + e] * g1[e] + cw[2 * NUP + j0 + e] * g0[e];
            const float vv = cw[DFF + j0 + e] * v2[e] + cw[NUP + DFF + j0 + e] * v1[e] + cw[2 * NUP + DFF + j0 + e] * v0[e];
            o[e] = silu_f(gg) * vv; }
        *(v4u*)(ACT + (size_t)(G * 64 + lr) * DFF + j0) = pack8(o);
    }
}

__device__ __forceinline__ void phase_final(const Args& a, int lane, int wave) {
    const float* mod = (const float*)(a.ws + WS_MOD); const bf16* Yb = (const bf16*)(a.ws + WS_Y2);
    const int NGW = gridDim.x * NWAVES;
    for (int rb = blockIdx.x * NWAVES + wave; rb < M / 16; rb += NGW) {
        const int m0 = rb * 16, b = m0 >> 14; const float* mb = mod + b * 12288;
        float G[4][8];
#pragma unroll
        for (int j = 0; j < 4; ++j)
#pragma unroll
            for (int e = 0; e < 8; ++e) { const int col = 512 * j + 8 * lane + e; G[j][e] = mb[10240 + col] * a.in[I_FPOST][col]; }
        for (int r = 0; r < 16; ++r) {
            const size_t ro = (size_t)(m0 + r) * D + 8 * lane;
            float y[4][8]; float ss = 0.f;
#pragma unroll
            for (int j = 0; j < 4; ++j) { unpack8(*(const v4u*)(Yb + ro + 512 * j), y[j]);
#pragma unroll
                for (int e = 0; e < 8; ++e) ss += y[j][e] * y[j][e]; }
            const float rstd = rsqrtf(wave_sum(ss) * (1.0f / D) + EPS);
#pragma unroll
            for (int j = 0; j < 4; ++j) { f32x4 xa = *(const f32x4*)(a.out + ro + 512 * j), xb = *(const f32x4*)(a.out + ro + 512 * j + 4);
#pragma unroll
                for (int e = 0; e < 4; ++e) { xa[e] += G[j][e] * (y[j][e] * rstd); xb[e] += G[j][e + 4] * (y[j][e + 4] * rstd); }
                *(f32x4*)(a.out + ro + 512 * j) = xa; *(f32x4*)(a.out + ro + 512 * j + 4) = xb; }
        }
    }
}

#define RLX_AGENT __ATOMIC_RELAXED, __HIP_MEMORY_SCOPE_AGENT
#define XB_TMO      128
#define XB_XCNT(j)  (256  + 64 * (j))
#define XB_XSUB(j)  (1280 + 64 * (j))
#define XB_XGEN(j)  (2304 + 64 * (j))
#define XB_TOP      3328
#define XB_TOPGEN   3392
#define XCD_BAR_WORDS 3456
#define XB_SPIN_CAP (1u << 18)

__device__ __forceinline__ unsigned xb_ld(unsigned* p)              { return __hip_atomic_load(p, __ATOMIC_RELAXED, __HIP_MEMORY_SCOPE_AGENT); }
__device__ __forceinline__ unsigned xb_add(unsigned* p, unsigned v) { return __hip_atomic_fetch_add(p, v, __ATOMIC_RELAXED, __HIP_MEMORY_SCOPE_AGENT); }
__device__ __forceinline__ unsigned xb_xcc_id() { return (unsigned)__builtin_amdgcn_s_getreg((3 << 11) | 20) & 0xFu; }
#define XB_SPIN(cond, bar) do { unsigned _sp = 0; while (cond) { __builtin_amdgcn_s_sleep(1); \
    if ((++_sp & 255u) == 0u) { if (xb_ld(&(bar)[XB_TMO])) break; if (_sp > XB_SPIN_CAP) { atomicAdd(&(bar)[XB_TMO], 1u); break; } } } } while (0)

struct XcdBarrier {
    unsigned* bar; unsigned x;
    volatile LAS unsigned* st;
};

__device__ __forceinline__ XcdBarrier xcd_barrier_post(unsigned* bar, volatile LAS unsigned* st) {
    XcdBarrier b; b.bar = bar; b.x = xb_xcc_id(); b.st = st;
    if (threadIdx.x == 0) (void)xb_add(&bar[XB_XCNT(b.x)], 1u);
    return b;
}
__device__ __forceinline__ void xcd_barrier_complete(unsigned* bar, unsigned x, unsigned& nloc, unsigned& nx) {
    const unsigned G = gridDim.x * gridDim.y * gridDim.z;
    unsigned sum, cnt, mine, sp = 0u;
    for (;;) {
        sum = 0u; cnt = 0u; mine = 0u;
#pragma unroll
        for (unsigned j = 0; j < 16; ++j) { const unsigned c = xb_ld(&bar[XB_XCNT(j)]); sum += c; cnt += (c > 0u) ? 1u : 0u; mine = (j == x) ? c : mine; }
        if (sum == G) break;
        __builtin_amdgcn_s_sleep(1);
        if ((++sp & 255u) == 0u) { if (xb_ld(&bar[XB_TMO])) break; if (sp > XB_SPIN_CAP) { atomicAdd(&bar[XB_TMO], 1u); break; } }
    }
    nloc = mine > 0u ? mine : 1u; nx = cnt > 0u ? cnt : 1u;
}

__device__ __forceinline__ void xcd_barrier(const XcdBarrier& b) {
    asm volatile("s_waitcnt vmcnt(0)" ::: "memory");
    __syncthreads();
    if (threadIdx.x == 0) {
        unsigned* bar = b.bar;
        __builtin_amdgcn_s_waitcnt(0);
        unsigned nloc = b.st[0], nx = b.st[1];
        if (nloc == 0u) { xcd_barrier_complete(bar, b.x, nloc, nx); b.st[0] = nloc; b.st[1] = nx; }
        const unsigned old = xb_add(&bar[XB_XSUB(b.x)], 1u);
        const unsigned gen = old / nloc;
        if (old + 1u == (gen + 1u) * nloc) {
            __builtin_amdgcn_fence(__ATOMIC_RELEASE, "agent");
            asm volatile("s_waitcnt vmcnt(0)" ::: "memory");
            const unsigned og = xb_add(&bar[XB_TOP], 1u);
            const unsigned tg = og / nx;
            if (og + 1u == (tg + 1u) * nx) xb_add(&bar[XB_TOPGEN], 1u);
            else XB_SPIN(xb_ld(&bar[XB_TOPGEN]) == tg, bar);
            __builtin_amdgcn_fence(__ATOMIC_ACQUIRE, "agent");
            xb_add(&bar[XB_XGEN(b.x)], 1u);
            asm volatile("s_waitcnt vmcnt(0)" ::: "memory");
        } else {
            XB_SPIN(xb_ld(&bar[XB_XGEN(b.x)]) == gen, bar);
            __builtin_amdgcn_fence(__ATOMIC_ACQUIRE, "agent");
            asm volatile("s_waitcnt vmcnt(0)" ::: "memory");
        }
    }
    __syncthreads();
}

constexpr int N_PHASES = 12;
#ifndef REP_GEMM
#define REP_GEMM 1
#endif
#ifndef REP_A
#define REP_A 1
#endif
#ifndef REP_B
#define REP_B 1
#endif
#ifndef REP_C
#define REP_C 1
#endif
__global__ void __launch_bounds__(NT, 2) fwd_kernel(Args args) {
    extern __shared__ __attribute__((aligned(16))) unsigned char lds_raw[];
    LAS unsigned char* lds = (LAS unsigned char*)lds_raw;
    const int tid = threadIdx.x, lane = tid & 63, wave = __builtin_amdgcn_readfirstlane(tid >> 6);
    const int lo = args.ph_lo, hi = args.ph_hi; unsigned char* ws = args.ws;
    volatile LAS unsigned* bst = (volatile LAS unsigned*)(lds + LDS_BYTES - 64);
    if (tid < 2) bst[tid] = 0u;
    __syncthreads();
    XcdBarrier xbar; xbar.bar = (unsigned*)ws; xbar.x = 0; xbar.st = nullptr;
    if (hi - lo > 1) xbar = xcd_barrier_post((unsigned*)ws, bst);
    if (lo < 0) cg::this_grid().sync();
#define IN(k) (lo <= (k) && (k) < hi)
#define SEAM(k) do { if (IN(k) && IN((k) + 1)) { xcd_barrier(xbar); } } while (0)
    if (IN(0)) { for (int rep = 0; rep < REP_A; ++rep) { phase_prologue(args, lds, tid, lane, wave); __syncthreads(); } } SEAM(0);
    if (IN(1)) { for (int rep = 0; rep < REP_A; ++rep) { phase_h1(args, lane, wave); __syncthreads(); } } SEAM(1);
    if (IN(2)) { pg8::Gemm g{(const bf16*)(ws + WS_H), (const bf16*)(ws + WS_WIN), M, NIN, D}; pg8::StaticOrder S; S.init(M, NIN, gridDim.x, blockIdx.x);
        pg8::EpiB16 E{(bf16*)(ws + WS_PROJ), NIN};
        _Pragma("unroll") for (int rep = 0; rep < REP_GEMM; ++rep) { pg8::gemm_phase<pg8::EpiB16, pg8::StaticOrder, true, true>(lds, g, S, E); __syncthreads(); } } SEAM(2);
    if (IN(3)) { for (int rep = 0; rep < REP_B; ++rep) { phase_g1(args, lds, tid, lane, wave); __syncthreads(); } } SEAM(3);
    if (IN(4)) { phase_g2(args, tid); } SEAM(4);
    if (IN(5)) { for (int rep = 0; rep < REP_B; ++rep) { phase_g3(args, lds, tid, lane, wave); __syncthreads(); } } SEAM(5);
    if (IN(6)) { pg8::Gemm g{(const bf16*)(ws + WS_H), (const bf16*)(ws + WS_WOUT), M, D, D}; pg8::StaticOrder S; S.init(M, D, gridDim.x, blockIdx.x);
        pg8::EpiB16 E{(bf16*)(ws + WS_Y), D};
        _Pragma("unroll") for (int rep = 0; rep < REP_GEMM; ++rep) { pg8::gemm_phase<pg8::EpiB16, pg8::StaticOrder, true, true>(lds, g, S, E); __syncthreads(); } } SEAM(6);
    if (IN(7)) { for (int rep = 0; rep < REP_A; ++rep) { phase_mid(args, lane, wave); __syncthreads(); } } SEAM(7);
    if (IN(8)) { pg8::Gemm g{(const bf16*)(ws + WS_H), (const bf16*)(ws + WS_WUP), M, NUP, D}; pg8::StaticOrder S; S.init(M, NUP, gridDim.x, blockIdx.x);
        pg8::EpiConvGate E{(bf16*)(ws + WS_ACT), (bf16*)(ws + WS_HALO), args.in[I_FCONVW]};
        _Pragma("unroll") for (int rep = 0; rep < REP_GEMM; ++rep) { pg8::gemm_phase<pg8::EpiConvGate, pg8::StaticOrder, true, true>(lds, g, S, E); __syncthreads(); } } SEAM(8);
    if (IN(9)) { phase_fixup(args, tid); } SEAM(9);
    if (IN(10)) { pg8::Gemm g{(const bf16*)(ws + WS_ACT), (const bf16*)(ws + WS_WDN), M, D, DFF}; pg8::StaticOrder S; S.init(M, D, gridDim.x, blockIdx.x);
        pg8::EpiB16 E{(bf16*)(ws + WS_Y2), D};
        _Pragma("unroll") for (int rep = 0; rep < REP_GEMM; ++rep) { pg8::gemm_phase<pg8::EpiB16, pg8::StaticOrder, true, true>(lds, g, S, E); __syncthreads(); } } SEAM(10);
    if (IN(11)) { phase_final(args, lane, wave); }
#undef IN
#undef SEAM
}

#ifndef N_LAUNCH_MODE
#define N_LAUNCH_MODE 1
#endif
extern "C" void kernel_launch(void* const* d_in, const int* in_sizes, int n_in, void* d_out, int out_size, void* d_ws, size_t ws_size, hipStream_t stream) {
    static int grid = 0;
    if (grid == 0) {
        if (n_in != 17 || out_size != M * D || ws_size < WS_END) { fprintf(stderr, "kernel_launch: unexpected shapes (n_in %d out %d ws %zu)\n", n_in, out_size, ws_size); grid = -1; return; }
        int dev = 0, cus = 0, per_cu = 0;
        hipGetDevice(&dev); hipDeviceGetAttribute(&cus, hipDeviceAttributeMultiprocessorCount, dev);
        hipFuncSetAttribute((const void*)fwd_kernel, hipFuncAttributeMaxDynamicSharedMemorySize, LDS_BYTES);
        hipOccupancyMaxActiveBlocksPerMultiprocessor(&per_cu, (const void*)fwd_kernel, NT, LDS_BYTES);
        if (per_cu < 1) { fprintf(stderr, "kernel_launch: occupancy query says %d blocks per CU\n", per_cu); per_cu = 1; }
        (void)hipGetLastError();
        grid = cus * per_cu;
        fprintf(stderr, "kernel_launch: grid %d (cus %d x %d)\n", grid, cus, per_cu);
    }
    if (grid < 0) return;
    Args a{};
    for (int i = 0; i < 17; ++i) a.in[i] = (const float*)d_in[i];
    a.out = (float*)d_out; a.ws = (unsigned char*)d_ws;
#if N_LAUNCH_MODE == 1
    a.ph_lo = 0; a.ph_hi = N_PHASES;
    (void)hipMemsetAsync(d_ws, 0, 16384, stream);
    void* kargs[] = {&a};
    hipError_t e = hipLaunchCooperativeKernel((const void*)fwd_kernel, dim3(grid), dim3(NT), kargs, LDS_BYTES, stream);
    if (e != hipSuccess) fprintf(stderr, "cooperative launch failed: %s (grid %d)\n", hipGetErrorString(e), grid);
#else
    for (int p = 0; p < N_PHASES; ++p) { a.ph_lo = p; a.ph_hi = p + 1; hipLaunchKernelGGL(fwd_kernel, dim3(grid), dim3(NT), LDS_BYTES, stream, a); }
#endif
}
```

```cpp
#include <hip/hip_runtime.h>
#include <hip/hip_cooperative_groups.h>
#include <cstdio>
#include <cstdint>
namespace cg = cooperative_groups;
namespace pg8 {
#define PG8_LAS __attribute__((address_space(3)))
typedef unsigned short bf16_t;
typedef short bf16x8 __attribute__((ext_vector_type(8)));
typedef float f32x4 __attribute__((ext_vector_type(4)));
typedef unsigned u32x4 __attribute__((ext_vector_type(4)));
typedef unsigned u32x2 __attribute__((ext_vector_type(2)));
typedef float f32x2 __attribute__((ext_vector_type(2)));
constexpr int BM = 256, BK = 64, HALF = 128, HTB = HALF * BK * 2  , STAGE_BYTES = 8 * HTB, NXCD = 8, WGM = 8;

__host__ __device__ __forceinline__ int lds_byte(int r, int c) { const int st = (r >> 4) * 2 + (c >> 5), rr = r & 15, cc = c & 31, ob = rr * 64 + cc * 2; return st * 1024 + (ob ^ (((ob >> 9) & 1) << 5)); }
__host__ __device__ __forceinline__ void stage_rc(int b, int& R, int& C) { const int st = b / 1024, sb = b % 1024, swz = sb ^ (((sb >> 9) & 1) << 5); R = (st >> 1) * 16 + swz / 64; C = (st & 1) * 32 + (swz % 64) / 2; }
__host__ __device__ __forceinline__ int perm32(int rho) { const int n = rho >> 4, i = rho & 15; return 8 * (i >> 2) + 4 * n + (i & 3); }

struct Unit { int pm, pn; };
struct Gemm { const bf16_t* A; const bf16_t* Bt; int M, N, K; };

struct StaticOrder {
    int nM, nN, nwg, G, c;
    __host__ __device__ void init(int M, int N, int G_, int c_) { nM = M / BM; nN = N / BM; nwg = nM * nN; G = G_; c = c_; }
    __host__ __device__ bool next(int i, Unit& u) const {
        const long L = (long)i * G + c; if (L >= nwg) return false;
        int wgid = (int)L; { const int q = nwg / NXCD, r = nwg % NXCD, xcd = wgid % NXCD, off = wgid / NXCD; wgid = (xcd < r ? xcd * (q + 1) : r * (q + 1) + (xcd - r) * q) + off; }
        const int nig = WGM * nN, gid = wgid / nig, fm = gid * WGM, gsz = (nM - fm) < WGM ? (nM - fm) : WGM;
        u.pm = fm + ((wgid % nig) % gsz); u.pn = (wgid % nig) / gsz; return true;
    }
    __device__ __forceinline__ void a_ready(const Unit&) const {}
    __device__ __forceinline__ void done(const Unit&) const {}
};

__device__ __forceinline__ unsigned cvt_pk_bf16(float lo, float hi) { unsigned r; asm volatile("v_cvt_pk_bf16_f32 %0, %1, %2" : "=v"(r) : "v"(lo), "v"(hi)); return r; }
typedef float cvt_f32x2_t __attribute__((ext_vector_type(2))); typedef __bf16 cvt_bf16x2_t __attribute__((ext_vector_type(2)));
__device__ __forceinline__ unsigned cvt_pk_bf16_safe(float lo, float hi) { cvt_f32x2_t v = {lo, hi}; cvt_bf16x2_t b = __builtin_convertvector(v, cvt_bf16x2_t); return __builtin_bit_cast(unsigned, b); }
#define PG8_MFMA_SETTLE() asm volatile("s_nop 7\n\ts_nop 7\n\ts_nop 7" ::: "memory")
struct EpiB16 {
    static constexpr bool PERM = true, AFTER_DRAIN = false;
    bf16_t* O; int ldc;
    __device__ __forceinline__ void operator()(const f32x4 (&acc)[2][2][4][2], const Unit& u, int wr, int wc, int fr, int fq) const {
        PG8_MFMA_SETTLE();
        const int row0 = u.pm * BM + wr * 64 + fr, col0 = u.pn * BM + wc * 32 + 8 * fq;
#pragma unroll
        for (int ai = 0; ai < 2; ++ai)
#pragma unroll
            for (int m = 0; m < 4; ++m) { bf16_t* rowp = O + (size_t)(row0 + ai * HALF + m * 16) * ldc + col0;
#pragma unroll
                for (int bj = 0; bj < 2; ++bj) { const f32x4 v0 = acc[ai][bj][m][0], v1 = acc[ai][bj][m][1];
                    u32x4 w; w.x = cvt_pk_bf16(v0[0], v0[1]); w.y = cvt_pk_bf16(v0[2], v0[3]); w.z = cvt_pk_bf16(v1[0], v1[1]); w.w = cvt_pk_bf16(v1[2], v1[3]);
                    *(u32x4*)(rowp + bj * HALF) = w; } }
    }
};
struct EpiProj {
    static constexpr bool PERM = true, AFTER_DRAIN = false;
    bf16_t* O; float* alr;
    __device__ __forceinline__ void operator()(const f32x4 (&acc)[2][2][4][2], const Unit& u, int wr, int wc, int fr, int fq) const {
        PG8_MFMA_SETTLE();
        const int row0 = u.pm * BM + wr * 64 + fr;
        if (u.pn < 24) {
            const int col0 = u.pn * BM + wc * 32 + 8 * fq;
#pragma unroll
            for (int ai = 0; ai < 2; ++ai)
#pragma unroll
                for (int m = 0; m < 4; ++m) { bf16_t* rowp = O + (size_t)(row0 + ai * HALF + m * 16) * 6144 + col0;
#pragma unroll
                    for (int bj = 0; bj < 2; ++bj) { const f32x4 v0 = acc[ai][bj][m][0], v1 = acc[ai][bj][m][1];
                        u32x4 w; w.x = cvt_pk_bf16(v0[0], v0[1]); w.y = cvt_pk_bf16(v0[2], v0[3]); w.z = cvt_pk_bf16(v1[0], v1[1]); w.w = cvt_pk_bf16(v1[2], v1[3]);
                        *(u32x4*)(rowp + bj * HALF) = w; } }
        } else if (wc == 0 && fq < 2) {
#pragma unroll
            for (int ai = 0; ai < 2; ++ai)
#pragma unroll
                for (int m = 0; m < 4; ++m) { float* rp = alr + (size_t)(row0 + ai * HALF + m * 16) * 16 + 8 * fq;
                    *(f32x4*)rp = acc[ai][0][m][0]; *(f32x4*)(rp + 4) = acc[ai][0][m][1]; }
        }
    }
};

template <int CTRL> __device__ __forceinline__ float dpp_ror(float v) { return __builtin_bit_cast(float, __builtin_amdgcn_update_dpp(0, __builtin_bit_cast(int, v), CTRL, 0xf, 0xf, false)); }
struct EpiConvGate {
    static constexpr bool PERM = true, AFTER_DRAIN = false;
    bf16_t* ACT; bf16_t* HALO; const float* cw;
    __device__ __forceinline__ void operator()(const f32x4 (&acc)[2][2][4][2], const Unit& u, int wr, int wc, int fr, int fq) const {
        PG8_MFMA_SETTLE();
        constexpr int NUPc = 11264, DFFc = 5632;
        const int j0 = u.pn * 128 + wc * 32 + 8 * fq;
        const int ucol = u.pn * BM + wc * 32 + 8 * fq;
        f32x4 wg[2][3], wv[2][3];
#pragma unroll
        for (int k = 0; k < 3; ++k) { wg[0][k] = *(const f32x4*)(cw + k * NUPc + j0); wv[0][k] = *(const f32x4*)(cw + k * NUPc + DFFc + j0); }
#pragma unroll
        for (int ai = 0; ai < 2; ++ai) {
            const int grp = u.pm * 4 + ai * 2 + wr;
            if (fr < 2 || fr >= 14) { const int rr = fr < 2 ? fr : fr - 12; bf16_t* hp = HALO + ((size_t)grp * 4 + rr) * NUPc + ucol;
#pragma unroll
                for (int bj = 0; bj < 2; ++bj) { const f32x4 v0 = fr < 2 ? acc[ai][bj][0][0] : acc[ai][bj][3][0], v1 = fr < 2 ? acc[ai][bj][0][1] : acc[ai][bj][3][1];
                    u32x4 w; w.x = cvt_pk_bf16(v0[0], v0[1]); w.y = cvt_pk_bf16(v0[2], v0[3]); w.z = cvt_pk_bf16(v1[0], v1[1]); w.w = cvt_pk_bf16(v1[2], v1[3]);
                    *(u32x4*)(hp + bj * HALF) = w; } }
        }
#pragma unroll
        for (int n = 0; n < 2; ++n) {
            if (n == 1) {
                asm volatile("" ::: "memory"); __builtin_amdgcn_sched_barrier(0);
#pragma unroll
                for (int k = 0; k < 3; ++k) { wg[1][k] = *(const f32x4*)(cw + k * NUPc + j0 + 4); wv[1][k] = *(const f32x4*)(cw + k * NUPc + DFFc + j0 + 4); } }
#pragma unroll
            for (int ai = 0; ai < 2; ++ai) {
                __builtin_amdgcn_sched_barrier(0);
                const int jc = j0 + 4 * n;
                f32x2 o[4][2];
#pragma unroll
                for (int xp = 0; xp < 2; ++xp) {
                    const f32x2 a0 = (f32x2){wg[n][0][2 * xp], wg[n][0][2 * xp + 1]}, a1 = (f32x2){wg[n][1][2 * xp], wg[n][1][2 * xp + 1]}, a2 = (f32x2){wg[n][2][2 * xp], wg[n][2][2 * xp + 1]};
                    const f32x2 b0 = (f32x2){wv[n][0][2 * xp], wv[n][0][2 * xp + 1]}, b1 = (f32x2){wv[n][1][2 * xp], wv[n][1][2 * xp + 1]}, b2 = (f32x2){wv[n][2][2 * xp], wv[n][2][2 * xp + 1]};
                    f32x2 g1p = (f32x2){0.f, 0.f}, g2p = g1p, v1p = g1p, v2p = g1p;
#pragma unroll
                    for (int m = 0; m < 4; ++m) {
                        const f32x2 g = (f32x2){acc[ai][0][m][n][2 * xp], acc[ai][0][m][n][2 * xp + 1]}, v = (f32x2){acc[ai][1][m][n][2 * xp], acc[ai][1][m][n][2 * xp + 1]};
                        f32x2 g1, g2, v1, v2, ga, gb, va, vb;
#pragma unroll
                        for (int c = 0; c < 2; ++c) { g1[c] = dpp_ror<0x121>(g[c]); g2[c] = dpp_ror<0x122>(g[c]); v1[c] = dpp_ror<0x121>(v[c]); v2[c] = dpp_ror<0x122>(v[c]);
                            ga[c] = fr == 0 ? g1p[c] : g1[c]; gb[c] = fr < 2 ? g2p[c] : g2[c]; va[c] = fr == 0 ? v1p[c] : v1[c]; vb[c] = fr < 2 ? v2p[c] : v2[c]; }
                        const f32x2 G = a0 * gb + a1 * ga + a2 * g, V = b0 * vb + b1 * va + b2 * v;
                        const f32x2 t = G * (-1.4426950408889634f);
                        f32x2 e; e.x = __builtin_amdgcn_exp2f(t.x); e.y = __builtin_amdgcn_exp2f(t.y);
                        const f32x2 dn = e + 1.0f;
                        f32x2 rc; rc.x = __builtin_amdgcn_rcpf(dn.x); rc.y = __builtin_amdgcn_rcpf(dn.y);
                        o[m][xp] = (G * rc) * V;
                        g1p = g1; g2p = g2; v1p = v1; v2p = v2;
                    }
                }
#pragma unroll
                for (int m = 0; m < 4; ++m) { const int row = u.pm * BM + ai * HALF + wr * 64 + m * 16 + fr;
                    u32x2 w; w.x = cvt_pk_bf16(o[m][0].x, o[m][0].y); w.y = cvt_pk_bf16(o[m][1].x, o[m][1].y);
                    if (m > 0 || fr >= 2) *(u32x2*)(ACT + (size_t)row * DFFc + jc) = w; }
            }
        }
    }
};

template <class Epi, class Sched, bool ALIGN_EPI = false, bool SP2 = false>
__device__ __forceinline__ void gemm_phase(PG8_LAS unsigned char* lds, const Gemm g, const Sched& S, const Epi& E) {
    const int tid = threadIdx.x, wid = __builtin_amdgcn_readfirstlane(tid >> 6), lane = tid & 63, wr = wid >> 2, wc = wid & 3, fr = lane & 15, fq = lane >> 4;
    const int K = g.K, nt = K / BK;
    unsigned voffA[2], voffB[2];
#pragma unroll
    for (int i = 0; i < 2; ++i) { int R, C; stage_rc(tid * 16 + i * 8192, R, C); const int Rb = Epi::PERM ? ((R & ~31) + perm32(R & 31)) : R;
        voffA[i] = (unsigned)(R * K + C) * 2u; voffB[i] = (unsigned)(Rb * K + C) * 2u; }
    const size_t kstep = (size_t)(BK * 2);
    const size_t hstep = (size_t)HALF * K * 2;
    const size_t tstep = 2 * hstep;
    const unsigned ldsw = (unsigned)wid * 1024u;
    const int aoff = lds_byte(wr * 64 + fr, fq * 8), boff = lds_byte(wc * 32 + fr, fq * 8);
#define PG8_SA(b, h) (((b) * 2 + (h)) * HTB)
#define PG8_SB(b, h) ((4 + (b) * 2 + (h)) * HTB)
#define PG8_STAGE(bufoff, gbase, voff) do { _Pragma("unroll") for (int _i = 0; _i < 2; ++_i) \
        __builtin_amdgcn_global_load_lds((const unsigned*)((const char*)(gbase) + (voff)[_i]), (PG8_LAS unsigned*)(lds + (bufoff) + ldsw + _i * 8192), 16, 0, 0); } while (0)
#define PG8_LDA(dst, b, h) do { _Pragma("unroll") for (int m = 0; m < 4; ++m) _Pragma("unroll") for (int k = 0; k < 2; ++k) dst[m][k] = *(const PG8_LAS bf16x8*)(lds + PG8_SA(b, h) + aoff + m * 2048 + k * 1024); } while (0)
#define PG8_LDB(dst, b, h) do { _Pragma("unroll") for (int n = 0; n < 2; ++n) _Pragma("unroll") for (int k = 0; k < 2; ++k) dst[n][k] = *(const PG8_LAS bf16x8*)(lds + PG8_SB(b, h) + boff + n * 2048 + k * 1024); } while (0)
#define PG8_MMA(ai, bj, At, Bt) do { __builtin_amdgcn_s_setprio(1); _Pragma("unroll") for (int m = 0; m < 4; ++m) _Pragma("unroll") for (int n = 0; n < 2; ++n) _Pragma("unroll") for (int k = 0; k < 2; ++k) \
        acc[ai][bj][m][n] = __builtin_amdgcn_mfma_f32_16x16x32_bf16(Bt[n][k], At[m][k], acc[ai][bj][m][n], 0, 0, 0); __builtin_amdgcn_s_setprio(0); } while (0)
#define PG8_WAIT_V(n) asm volatile("s_waitcnt vmcnt(" #n ")" ::: "memory")
#define PG8_WAIT_L(n) asm volatile("s_waitcnt lgkmcnt(" #n ")" ::: "memory")
#define PG8_BAR __builtin_amdgcn_s_barrier()
#define PG8_SCHED __builtin_amdgcn_sched_barrier(0)
    Unit cur, nxt; int ui = 0;
    if (!S.next(0, cur)) return;
    f32x4 acc[2][2][4][2];
#pragma unroll
    for (int a = 0; a < 2; ++a)
#pragma unroll
        for (int b = 0; b < 2; ++b)
#pragma unroll
            for (int m = 0; m < 4; ++m)
#pragma unroll
                for (int n = 0; n < 2; ++n) acc[a][b][m][n] = (f32x4){0.f, 0.f, 0.f, 0.f};
    bf16x8 At[4][2], B0[2][2], B1[2][2];
    const char* cA = (const char*)g.A + (size_t)cur.pm * tstep; const char* cB = (const char*)g.Bt + (size_t)cur.pn * tstep;
    S.a_ready(cur);
    if constexpr (SP2) {
        PG8_STAGE(PG8_SB(0, 0), cB, voffB); PG8_STAGE(PG8_SB(0, 1), cB + hstep, voffB); PG8_STAGE(PG8_SA(0, 0), cA, voffA); PG8_STAGE(PG8_SA(0, 1), cA + hstep, voffA);
        if (wr == 1) PG8_BAR;
        PG8_WAIT_V(2); PG8_BAR;
        PG8_STAGE(PG8_SB(1, 0), cB + kstep, voffB); PG8_STAGE(PG8_SA(1, 0), cA + kstep, voffA); PG8_STAGE(PG8_SB(1, 1), cB + hstep + kstep, voffB);
        PG8_WAIT_V(6); PG8_BAR;
    } else {
        PG8_STAGE(PG8_SB(0, 0), cB, voffB); PG8_STAGE(PG8_SA(0, 0), cA, voffA); PG8_STAGE(PG8_SB(0, 1), cB + hstep, voffB); PG8_STAGE(PG8_SA(0, 1), cA + hstep, voffA);
        if (wr == 1) PG8_BAR;
        PG8_WAIT_V(4); PG8_BAR;
        PG8_STAGE(PG8_SB(1, 0), cB + kstep, voffB); PG8_STAGE(PG8_SA(1, 0), cA + kstep, voffA); PG8_STAGE(PG8_SB(1, 1), cB + hstep + kstep, voffB);
        PG8_WAIT_V(6); PG8_BAR;
    }
    for (;;) {
        const bool has_next = S.next(ui + 1, nxt);
        const char* nA = has_next ? (const char*)g.A + (size_t)nxt.pm * tstep : cA; const char* nB = has_next ? (const char*)g.Bt + (size_t)nxt.pn * tstep : cB;
        for (int t = 0; t < nt; t += 2) {
            const bool last = (t == nt - 2);
            const char* a1 = cA + (size_t)(t + 1) * kstep;
            const char* a2 = last ? nA : cA + (size_t)(t + 2) * kstep; const char* b2 = last ? nB : cB + (size_t)(t + 2) * kstep;
            const char* a3 = a2 + kstep; const char* b3 = b2 + kstep;
            if (last && has_next) S.a_ready(nxt);
            if constexpr (SP2) {
            PG8_LDB(B0, 0, 0); PG8_LDB(B1, 0, 1); PG8_SCHED; PG8_LDA(At, 0, 0); PG8_STAGE(PG8_SA(1, 1), a1 + hstep, voffA);
            PG8_WAIT_V(8); PG8_WAIT_L(0); PG8_BAR; PG8_MMA(0, 0, At, B0); PG8_MMA(0, 1, At, B1); PG8_BAR; PG8_SCHED;
            PG8_LDA(At, 0, 1); PG8_STAGE(PG8_SB(0, 0), b2, voffB); PG8_STAGE(PG8_SB(0, 1), b2 + hstep, voffB); PG8_STAGE(PG8_SA(0, 0), a2, voffA);
            PG8_WAIT_V(8); PG8_WAIT_L(0); PG8_BAR; PG8_MMA(1, 0, At, B0); PG8_MMA(1, 1, At, B1); PG8_BAR; PG8_SCHED;
            PG8_LDB(B0, 1, 0); PG8_LDB(B1, 1, 1); PG8_SCHED; PG8_LDA(At, 1, 0); PG8_STAGE(PG8_SA(0, 1), a2 + hstep, voffA);
            PG8_WAIT_V(8); PG8_WAIT_L(0); PG8_BAR; PG8_MMA(0, 0, At, B0); PG8_MMA(0, 1, At, B1); PG8_BAR; PG8_SCHED;
            PG8_LDA(At, 1, 1); PG8_STAGE(PG8_SB(1, 0), b3, voffB); PG8_STAGE(PG8_SB(1, 1), b3 + hstep, voffB); PG8_STAGE(PG8_SA(1, 0), a3, voffA);
            PG8_WAIT_V(8); PG8_WAIT_L(0); PG8_BAR; PG8_MMA(1, 0, At, B0); PG8_MMA(1, 1, At, B1); PG8_BAR; PG8_SCHED;
            } else {
            PG8_LDB(B0, 0, 0); PG8_SCHED; PG8_LDA(At, 0, 0); PG8_STAGE(PG8_SA(1, 1), a1 + hstep, voffA);
            PG8_WAIT_L(8); PG8_BAR; PG8_WAIT_L(0); PG8_MMA(0, 0, At, B0); PG8_BAR; PG8_SCHED;
            PG8_LDB(B1, 0, 1); PG8_STAGE(PG8_SB(0, 0), b2, voffB);
            PG8_BAR; PG8_WAIT_L(0); PG8_MMA(0, 1, At, B1); PG8_BAR;
            PG8_LDA(At, 0, 1); PG8_STAGE(PG8_SA(0, 0), a2, voffA);
            PG8_BAR; PG8_WAIT_L(0); PG8_MMA(1, 0, At, B0); PG8_BAR; PG8_SCHED;
            PG8_STAGE(PG8_SB(0, 1), b2 + hstep, voffB);
            PG8_WAIT_V(6); PG8_BAR; PG8_MMA(1, 1, At, B1); PG8_BAR;
            PG8_LDB(B0, 1, 0); PG8_SCHED; PG8_LDA(At, 1, 0); PG8_STAGE(PG8_SA(0, 1), a2 + hstep, voffA);
            PG8_WAIT_L(8); PG8_BAR; PG8_WAIT_L(0); PG8_MMA(0, 0, At, B0); PG8_BAR; PG8_SCHED;
            PG8_LDB(B1, 1, 1); PG8_STAGE(PG8_SB(1, 0), b3, voffB);
            PG8_BAR; PG8_WAIT_L(0); PG8_MMA(0, 1, At, B1); PG8_BAR;
            PG8_LDA(At, 1, 1); PG8_STAGE(PG8_SA(1, 0), a3, voffA);
            PG8_BAR; PG8_WAIT_L(0); PG8_MMA(1, 0, At, B0); PG8_BAR; PG8_SCHED;
            PG8_STAGE(PG8_SB(1, 1), b3 + hstep, voffB);
            PG8_WAIT_V(6); PG8_BAR; PG8_MMA(1, 1, At, B1); PG8_BAR;
            }
        }
        if constexpr (ALIGN_EPI) { if (wr == 0) PG8_BAR; }
        if constexpr (!Epi::AFTER_DRAIN) { E(acc, cur, wr, wc, fr, fq); S.done(cur); }
        if (!has_next) break;
#pragma unroll
        for (int a = 0; a < 2; ++a)
#pragma unroll
            for (int b = 0; b < 2; ++b)
#pragma unroll
                for (int m = 0; m < 4; ++m)
#pragma unroll
                    for (int n = 0; n < 2; ++n) acc[a][b][m][n] = (f32x4){0.f, 0.f, 0.f, 0.f};
        cur = nxt; cA = nA; cB = nB; ++ui;
        if constexpr (ALIGN_EPI) { if (wr == 1) PG8_BAR; }
    }
    PG8_WAIT_V(0);
    if constexpr (!ALIGN_EPI) { if (wr == 0) PG8_BAR; }
    PG8_BAR;
    if constexpr (Epi::AFTER_DRAIN) { E.fused(acc, cur, wr, wc, fr, fq, lds, wid, lane); S.done(cur); }
#undef PG8_SA
#undef PG8_SB
#undef PG8_STAGE
#undef PG8_LDA
#undef PG8_LDB
#undef PG8_MMA
#undef PG8_WAIT_V
#undef PG8_WAIT_L
#undef PG8_BAR
#undef PG8_SCHED
}
}

constexpr int NWAVES = 8, NT = 512;
constexpr int SEQ = 16384, M = 32768, D = 2048, NIN = 6144, NINP = 6400, NIN_SRC = 6160, DFF = 5632, NUP = 11264, MH = 16384;
constexpr int C_CB = 0, C_CC = 1024, C_CX = 2048, C_Q = 3072, C_K = 3584, C_V = 4096, C_R = 5120;
constexpr float EPS = 1e-6f;
constexpr size_t MiB = 1u << 20;
constexpr size_t WS_MOD = 1 * MiB;
constexpr size_t WS_WIN = 2 * MiB, WS_WOUT = 27 * MiB, WS_WUP = 35 * MiB, WS_WDN = 79 * MiB;
constexpr size_t WS_H = 104 * MiB;
constexpr size_t WS_PROJ = 232 * MiB;
constexpr size_t WS_ALR = 616 * MiB;
constexpr size_t WS_S = 618 * MiB;
constexpr size_t WS_DEC = 746 * MiB;
constexpr size_t WS_Y = 748 * MiB;
constexpr size_t WS_HALO = 232 * MiB;
constexpr size_t WS_ACT = 584 * MiB;
constexpr size_t WS_Y2 = 232 * MiB;
constexpr size_t WS_END = 936 * MiB;
constexpr int LDS_BYTES = 147456;

#define GAS __attribute__((address_space(1)))
#define LAS __attribute__((address_space(3)))
typedef unsigned short bf16;
typedef unsigned v4u __attribute__((ext_vector_type(4)));
typedef unsigned v2u __attribute__((ext_vector_type(2)));
typedef float f32x4 __attribute__((ext_vector_type(4)));
typedef float f32x2 __attribute__((ext_vector_type(2)));
typedef short bf16x8 __attribute__((ext_vector_type(8)));
#define LDS_WAIT() asm volatile("s_waitcnt lgkmcnt(0)" ::: "memory")

__device__ __forceinline__ unsigned pk2(float lo, float hi) { return pg8::cvt_pk_bf16_safe(lo, hi); }
__device__ __forceinline__ float bflo(unsigned w) { return __uint_as_float(w << 16); }
__device__ __forceinline__ float bfhi(unsigned w) { return __uint_as_float(w & 0xffff0000u); }
__device__ __forceinline__ float bf1(bf16 b) { return __uint_as_float(((unsigned)b) << 16); }
__device__ __forceinline__ float silu_f(float v) { return v / (1.0f + __expf(-v)); }
__device__ __forceinline__ float wave_sum(float v) {
#pragma unroll
    for (int o = 1; o < 64; o <<= 1) v += __shfl_xor(v, o);
    return v;
}
__device__ __forceinline__ void unpack8(const v4u w, float (&f)[8]) {
    f[0] = bflo(w.x); f[1] = bfhi(w.x); f[2] = bflo(w.y); f[3] = bfhi(w.y); f[4] = bflo(w.z); f[5] = bfhi(w.z); f[6] = bflo(w.w); f[7] = bfhi(w.w);
}
__device__ __forceinline__ v4u pack8(const float (&f)[8]) { v4u w; w.x = pk2(f[0], f[1]); w.y = pk2(f[2], f[3]); w.z = pk2(f[4], f[5]); w.w = pk2(f[6], f[7]); return w; }

struct Args { const float* in[17]; float* out; unsigned char* ws; int ph_lo, ph_hi; };
enum { I_X = 0, I_C, I_WMOD, I_BMOD, I_MIXPRE, I_MIXPOST, I_WIN, I_CONVW, I_GW2, I_GB, I_GNW, I_WOUT, I_FPRE, I_FPOST, I_WUP, I_FCONVW, I_WDN };

__device__ __forceinline__ void transpose_item(const float* W, int K, int N, int k0, int n0, int ncols, bf16* WT, int drow0, LAS float* scr, int lane) {
    const int c4 = lane & 7, kr = lane >> 3; const bool cv = 4 * c4 < ncols;
    f32x4 wl[8];
#pragma unroll
    for (int i = 0; i < 8; ++i) wl[i] = cv ? *(const f32x4*)(W + (size_t)(k0 + 8 * i + kr) * N + n0 + 4 * c4) : (f32x4){0.f, 0.f, 0.f, 0.f};
#pragma unroll
    for (int i = 0; i < 8; ++i) { LAS float* sp = scr + (8 * i + kr) * 33 + 4 * c4; sp[0] = wl[i].x; sp[1] = wl[i].y; sp[2] = wl[i].z; sp[3] = wl[i].w; }
    LDS_WAIT(); asm volatile("" ::: "memory");
    const int c = lane & 7;
#pragma unroll
    for (int j = 0; j < 4; ++j) { const int n = (lane >> 3) + 8 * j; const LAS float* s = scr + (8 * c) * 33 + n;
        v4u o; o.x = pk2(s[0 * 33], s[1 * 33]); o.y = pk2(s[2 * 33], s[3 * 33]); o.z = pk2(s[4 * 33], s[5 * 33]); o.w = pk2(s[6 * 33], s[7 * 33]);
        if (n < ncols) *(v4u*)(WT + (size_t)(drow0 + n) * K + k0 + 8 * c) = o; }
    LDS_WAIT(); asm volatile("" ::: "memory");
}

__device__ __forceinline__ void phase_prologue(const Args& a, LAS unsigned char* lds, int tid, int lane, int wave) {
    unsigned char* ws = a.ws;
    if (blockIdx.x < 192) {
        LAS float* ca = (LAS float*)lds;
        LAS float* red = (LAS float*)(lds + 16384);
        const float* c = a.in[I_C];
        for (int i = tid; i < 4096; i += NT) ca[i] = silu_f(c[i]);
        __syncthreads();
        const int col = blockIdx.x * 64 + lane; const float* wm = a.in[I_WMOD] + col;
        float a0 = 0.f, a1 = 0.f;
        for (int k0 = wave * 256; k0 < wave * 256 + 256; k0 += 32) {
            float wv[32];
#pragma unroll
            for (int i = 0; i < 32; ++i) wv[i] = wm[(size_t)(k0 + i) * 12288];
#pragma unroll
            for (int i = 0; i < 32; ++i) { a0 += ca[k0 + i] * wv[i]; a1 += ca[2048 + k0 + i] * wv[i]; } }
        red[(wave * 2 + 0) * 64 + lane] = a0; red[(wave * 2 + 1) * 64 + lane] = a1;
        __syncthreads();
        if (tid < 128) { const int b = tid >> 6, l = tid & 63; float s = 0.f;
#pragma unroll
            for (int w = 0; w < 8; ++w) s += red[(w * 2 + b) * 64 + l];
            const int cc = blockIdx.x * 64 + l; ((float*)(ws + WS_MOD))[b * 12288 + cc] = s + a.in[I_BMOD][cc]; }
        __syncthreads();
    }
    LAS float* scr = (LAS float*)(lds + wave * 16384);
    const int gw = blockIdx.x * NWAVES + wave, NGW = gridDim.x * NWAVES;
    constexpr int IT_IN = 32 * 193, IT_OUT = 32 * 64, IT_UP = 32 * 352, IT_DN = 88 * 64;
    for (int it = gw; it < IT_IN + IT_OUT + IT_UP + IT_DN; it += NGW) {
        int r = it;
        if (r < IT_IN) { const int kb = r / 193, nb = r % 193; transpose_item(a.in[I_WIN], D, NIN_SRC, 64 * kb, 32 * nb, nb == 192 ? 16 : 32, (bf16*)(ws + WS_WIN), 32 * nb, scr, lane); continue; } r -= IT_IN;
        if (r < IT_OUT) { const int kb = r / 64, nb = r % 64; transpose_item(a.in[I_WOUT], D, D, 64 * kb, 32 * nb, 32, (bf16*)(ws + WS_WOUT), 32 * nb, scr, lane); continue; } r -= IT_OUT;
        if (r < IT_UP) { const int kb = r / 352, nb = r % 352; const int n0 = 32 * nb; const int jj = n0 < DFF ? n0 : n0 - DFF;
            const int drow = 256 * (jj >> 7) + (n0 < DFF ? 0 : 128) + (jj & 127);
            transpose_item(a.in[I_WUP], D, NUP, 64 * kb, n0, 32, (bf16*)(ws + WS_WUP), drow, scr, lane); continue; } r -= IT_UP;
        { const int kb = r / 64, nb = r % 64; transpose_item(a.in[I_WDN], DFF, D, 64 * kb, 32 * nb, 32, (bf16*)(ws + WS_WDN), 32 * nb, scr, lane); }
    }
}

__device__ __forceinline__ void phase_h1(const Args& a, int lane, int wave) {
    const float* mod = (const float*)(a.ws + WS_MOD); bf16* H = (bf16*)(a.ws + WS_H);
    const int NGW = gridDim.x * NWAVES;
    for (int rb = blockIdx.x * NWAVES + wave; rb < M / 16; rb += NGW) {
        const int m0 = rb * 16, b = m0 >> 14; const float* mb = mod + b * 12288;
        float A[4][8], B[4][8];
#pragma unroll
        for (int j = 0; j < 4; ++j)
#pragma unroll
            for (int e = 0; e < 8; ++e) { const int col = 512 * j + 8 * lane + e; A[j][e] = a.in[I_MIXPRE][col] * (1.0f + mb[2048 + col]); B[j][e] = mb[col]; }
        for (int r = 0; r < 16; ++r) {
            const float* xr = a.in[I_X] + (size_t)(m0 + r) * D + 8 * lane;
            f32x4 v[4][2]; float ss = 0.f;
#pragma unroll
            for (int j = 0; j < 4; ++j) { v[j][0] = *(const f32x4*)(xr + 512 * j); v[j][1] = *(const f32x4*)(xr + 512 * j + 4); }
#pragma unroll
            for (int j = 0; j < 4; ++j)
#pragma unroll
                for (int q = 0; q < 2; ++q) ss += (v[j][q].x * v[j][q].x + v[j][q].y * v[j][q].y) + (v[j][q].z * v[j][q].z + v[j][q].w * v[j][q].w);
            const float rstd = rsqrtf(wave_sum(ss) * (1.0f / D) + EPS);
            bf16* hr = H + (size_t)(m0 + r) * D + 8 * lane;
#pragma unroll
            for (int j = 0; j < 4; ++j) { float o[8];
#pragma unroll
                for (int e = 0; e < 8; ++e) o[e] = v[j][e >> 2][e & 3] * rstd * A[j][e] + B[j][e];
                *(v4u*)(hr + 512 * j) = pack8(o); }
        }
        asm volatile("s_waitcnt vmcnt(0)" ::: "memory");
        { const int r16 = lane & 15, q4 = lane >> 4;
          const bf16* hrow = H + (size_t)(m0 + r16) * D + 8 * q4; const bf16* wrow = (const bf16*)(a.ws + WS_WIN) + (size_t)(NIN + r16) * D + 8 * q4;
          f32x4 acc0 = (f32x4){0.f, 0.f, 0.f, 0.f}, acc1 = acc0;
          for (int ks = 0; ks < 64; ks += 8) {
              bf16x8 af[8], bf[8];
#pragma unroll
              for (int i = 0; i < 8; ++i) { af[i] = *(const bf16x8*)(hrow + 32 * (ks + i)); bf[i] = *(const bf16x8*)(wrow + 32 * (ks + i)); }
#pragma unroll
              for (int i = 0; i < 8; i += 2) { acc0 = __builtin_amdgcn_mfma_f32_16x16x32_bf16(af[i], bf[i], acc0, 0, 0, 0); acc1 = __builtin_amdgcn_mfma_f32_16x16x32_bf16(af[i + 1], bf[i + 1], acc1, 0, 0, 0); } }
          float* alr = (float*)(a.ws + WS_ALR);
#pragma unroll
          for (int x = 0; x < 4; ++x) alr[(size_t)(m0 + 4 * q4 + x) * 16 + r16] = acc0[x] + acc1[x]; }
    }
}

struct GateIn { f32x4 av; float w2r[16]; float gb; };
__device__ __forceinline__ void gates_load(const Args& a, int m0, int h, int tid, GateIn& g) {
    const float* alr = (const float*)(a.ws + WS_ALR) + (size_t)m0 * 16;
    g.av = (f32x4){0.f, 0.f, 0.f, 0.f};
    if (tid < 256) g.av = *(const f32x4*)(alr + 4 * tid);
    const int d = tid & 127;
#pragma unroll
    for (int r = 0; r < 16; ++r) g.w2r[r] = a.in[I_GW2][r * 512 + h * 128 + d];
    g.gb = a.in[I_GB][h * 128 + d];
}
__device__ __forceinline__ void gates_compute(const GateIn& g, LAS float* aL, LAS float* tot, int tid, float (&bq)[16], float& blast) {
    if (tid < 256) *(LAS f32x4*)(aL + 4 * tid) = g.av;
    const int d = tid & 127, ig = tid >> 7;
    __syncthreads();
    float run = 0.f;
#pragma unroll
    for (int ii = 0; ii < 16; ++ii) { const LAS f32x4* ar = (const LAS f32x4*)(aL + (16 * ig + ii) * 16); float z = g.gb;
#pragma unroll
        for (int r4 = 0; r4 < 4; ++r4) { const f32x4 av = ar[r4]; z += av.x * g.w2r[4 * r4] + av.y * g.w2r[4 * r4 + 1] + av.z * g.w2r[4 * r4 + 2] + av.w * g.w2r[4 * r4 + 3]; }
        const float ls = fminf(z, 0.f) - __logf(1.0f + __expf(-fabsf(z)));
        run += ls * (1.0f / 16.0f); bq[ii] = run; }
    tot[ig * 128 + d] = run;
    __syncthreads();
    float off = 0.f, all = 0.f;
#pragma unroll
    for (int gg = 0; gg < 4; ++gg) { const float t = tot[gg * 128 + d]; all += t; off += (gg < ig) ? t : 0.f; }
#pragma unroll
    for (int ii = 0; ii < 16; ++ii) bq[ii] += off;
    blast = all;
}

__device__ __forceinline__ void phase_g1(const Args& a, LAS unsigned char* lds, int tid, int lane, int wave) {
    LAS float* aL = (LAS float*)lds; LAS float* tot = (LAS float*)(lds + 4096); LAS bf16* kdT = (LAS bf16*)(lds + 8192);
    LAS bf16* Kr = (LAS bf16*)(lds + 26624); LAS bf16* Vs = (LAS bf16*)(lds + 44032);
    const bf16* proj = (const bf16*)(a.ws + WS_PROJ); bf16* S = (bf16*)(a.ws + WS_S); float* dec = (float*)(a.ws + WS_DEC);
    const int d = tid & 127, ig = tid >> 7, r16 = lane & 15, q4 = lane >> 4;
    GateIn gin; v4u kreg[2], vreg[4];
#define G1_LOADS(UNIT) do { const int bh_ = (UNIT) >> 8, n_ = (UNIT) & 255, h_ = bh_ & 3, m0_ = (bh_ >> 2) * SEQ + n_ * 64; gates_load(a, m0_, h_, tid, gin); \
        _Pragma("unroll") for (int s2 = 0; s2 < 2; ++s2) { const int c = tid + 512 * s2; kreg[s2] = *(const v4u*)(proj + (size_t)(m0_ + (c >> 4)) * NIN + C_K + h_ * 128 + 8 * (c & 15)); } \
        _Pragma("unroll") for (int s4 = 0; s4 < 4; ++s4) { const int c = tid + 512 * s4; vreg[s4] = *(const v4u*)(proj + (size_t)(m0_ + (c >> 5)) * NIN + C_V + h_ * 256 + 8 * (c & 31)); } } while (0)
    if ((int)blockIdx.x < 2048) G1_LOADS((int)blockIdx.x);
    for (int unit = blockIdx.x; unit < 2048; unit += gridDim.x) {
        const int bh = unit >> 8, n = unit & 255, b = bh >> 2, h = bh & 3, m0 = b * SEQ + n * 64;
        float bq[16], blast;
        gates_compute(gin, aL, tot, tid, bq, blast);
#pragma unroll
        for (int s2 = 0; s2 < 2; ++s2) { const int c = tid + 512 * s2; *(LAS v4u*)(Kr + (c >> 4) * 136 + 8 * (c & 15)) = kreg[s2]; }
#pragma unroll
        for (int s4 = 0; s4 < 4; ++s4) { const int c = tid + 512 * s4; *(LAS v4u*)(Vs + (c >> 5) * 264 + 8 * (c & 31)) = vreg[s4]; }
        { const int nu = unit + (int)gridDim.x; if (nu < 2048) G1_LOADS(nu); }
        __syncthreads();
        { float kd[16];
#pragma unroll
          for (int ii = 0; ii < 16; ++ii) kd[ii] = bf1(Kr[(16 * ig + ii) * 136 + d]) * __expf(blast - bq[ii]);
          v4u w0, w1; w0.x = pk2(kd[0], kd[1]); w0.y = pk2(kd[2], kd[3]); w0.z = pk2(kd[4], kd[5]); w0.w = pk2(kd[6], kd[7]);
          w1.x = pk2(kd[8], kd[9]); w1.y = pk2(kd[10], kd[11]); w1.z = pk2(kd[12], kd[13]); w1.w = pk2(kd[14], kd[15]);
          *(LAS v4u*)(kdT + d * 72 + 16 * ig) = w0; *(LAS v4u*)(kdT + d * 72 + 16 * ig + 8) = w1;
          if (ig == 0) dec[unit * 128 + d] = __expf(blast); }
        bf16x8 vf[2][2];
#pragma unroll
        for (int nt = 0; nt < 2; ++nt)
#pragma unroll
            for (int ks = 0; ks < 2; ++ks)
#pragma unroll
                for (int jj = 0; jj < 8; ++jj) vf[nt][ks][jj] = (short)Vs[(32 * ks + 8 * q4 + jj) * 264 + 32 * wave + 16 * nt + r16];
        __syncthreads();
        f32x4 acc[8][2];
#pragma unroll
        for (int mt = 0; mt < 8; ++mt)
#pragma unroll
            for (int nt = 0; nt < 2; ++nt) acc[mt][nt] = (f32x4){0.f, 0.f, 0.f, 0.f};
#pragma unroll
        for (int mt = 0; mt < 8; ++mt)
#pragma unroll
            for (int ks = 0; ks < 2; ++ks) { const bf16x8 af = *(const LAS bf16x8*)(kdT + (16 * mt + r16) * 72 + 32 * ks + 8 * q4);
#pragma unroll
                for (int nt = 0; nt < 2; ++nt) acc[mt][nt] = __builtin_amdgcn_mfma_f32_16x16x32_bf16(af, vf[nt][ks], acc[mt][nt], 0, 0, 0); }
        bf16* Su = S + (size_t)unit * 32768;
#pragma unroll
        for (int mt = 0; mt < 8; ++mt)
#pragma unroll
            for (int nt = 0; nt < 2; ++nt) { v2u w; w.x = pk2(acc[mt][nt][0], acc[mt][nt][1]); w.y = pk2(acc[mt][nt][2], acc[mt][nt][3]);
                *(v2u*)(Su + (32 * wave + 16 * nt + r16) * 128 + 16 * mt + 4 * q4) = w; }
        __syncthreads();
    }
#undef G1_LOADS
    bf16* Y = (bf16*)(a.ws + WS_H);
    for (int item = blockIdx.x; item < M / 64; item += gridDim.x) {
        const int c0 = 8 * (tid & 127), mr = item * 64 + 16 * (tid >> 7);
        float w0[8], w1[8], w2[8], p1[8], p2[8];
#pragma unroll
        for (int e = 0; e < 8; ++e) { w0[e] = a.in[I_CONVW][c0 + e]; w1[e] = a.in[I_CONVW][1024 + c0 + e]; w2[e] = a.in[I_CONVW][2048 + c0 + e]; p1[e] = 0.f; p2[e] = 0.f; }
        if ((mr & (SEQ - 1)) != 0) {
            float c1[8], x1[8]; const bf16* r2 = proj + (size_t)(mr - 2) * NIN + c0; const bf16* r1 = proj + (size_t)(mr - 1) * NIN + c0;
            unpack8(*(const v4u*)(r2 + C_CC), c1); unpack8(*(const v4u*)(r2 + C_CX), x1);
#pragma unroll
            for (int e = 0; e < 8; ++e) p2[e] = c1[e] * x1[e];
            unpack8(*(const v4u*)(r1 + C_CC), c1); unpack8(*(const v4u*)(r1 + C_CX), x1);
#pragma unroll
            for (int e = 0; e < 8; ++e) p1[e] = c1[e] * x1[e];
        }
        for (int r0 = 0; r0 < 16; r0 += 4) {
            v4u rb[4], rc[4], rx[4];
#pragma unroll
            for (int q = 0; q < 4; ++q) { const bf16* rp = proj + (size_t)(mr + r0 + q) * NIN + c0; rb[q] = *(const v4u*)(rp + C_CB); rc[q] = *(const v4u*)(rp + C_CC); rx[q] = *(const v4u*)(rp + C_CX); }
#pragma unroll
            for (int q = 0; q < 4; ++q) { float cb[8], cc[8], cx[8], o[8];
                unpack8(rb[q], cb); unpack8(rc[q], cc); unpack8(rx[q], cx);
#pragma unroll
                for (int e = 0; e < 8; ++e) { const float p0 = cc[e] * cx[e]; o[e] = cb[e] * (w0[e] * p2[e] + w1[e] * p1[e] + w2[e] * p0); p2[e] = p1[e]; p1[e] = p0; }
                *(v4u*)(Y + (size_t)(mr + r0 + q) * D + c0) = pack8(o); }
        }
    }
}

__device__ __forceinline__ void phase_g2(const Args& a, int tid) {
    unsigned* S = (unsigned*)(a.ws + WS_S); const float* dec = (const float*)(a.ws + WS_DEC);
    const int total = gridDim.x * NT;
    for (int idx = blockIdx.x * NT + tid; idx < 8 * 16384; idx += total) {
        const int bh = idx >> 14, r = idx & 16383, d0 = (2 * r) & 127;
        float s0 = 0.f, s1 = 0.f;
        for (int n0 = 0; n0 < 256; n0 += 16) {
            unsigned w[16]; f32x2 dd[16];
#pragma unroll
            for (int i = 0; i < 16; ++i) { const int unit = bh * 256 + n0 + i; w[i] = S[(size_t)unit * 16384 + r]; dd[i] = *(const f32x2*)(dec + unit * 128 + d0); }
#pragma unroll
            for (int i = 0; i < 16; ++i) { const int unit = bh * 256 + n0 + i; S[(size_t)unit * 16384 + r] = pk2(s0, s1);
                s0 = dd[i].x * s0 + bflo(w[i]); s1 = dd[i].y * s1 + bfhi(w[i]); }
        }
    }
}

__device__ __forceinline__ void phase_g3(const Args& a, LAS unsigned char* lds, int tid, int lane, int wave) {
    LAS float* aL = (LAS float*)lds; LAS float* tot = (LAS float*)(lds + 4096); LAS float* part = (LAS float*)(lds + 6144); LAS float* rstdL = (LAS float*)(lds + 8192);
    LAS bf16* Qs = (LAS bf16*)(lds + 8704); LAS bf16* Ks = (LAS bf16*)(lds + 8704 + 17408); LAS bf16* Ps = (LAS bf16*)(lds + 8704 + 2 * 17408);
    LAS bf16* Vs = (LAS bf16*)(lds + 52736); LAS bf16* Rs = (LAS bf16*)(lds + 86528);
    const bf16* proj = (const bf16*)(a.ws + WS_PROJ); const bf16* S = (const bf16*)(a.ws + WS_S); bf16* Y = (bf16*)(a.ws + WS_H);
    const int d = tid & 127, ig = tid >> 7, r16 = lane & 15, q4 = lane >> 4;
    GateIn gin; v4u qreg[2], kreg[2], vreg[4], rreg[4];
#define G3_LOADS(UNIT) do { const int bh_ = (UNIT) >> 8, n_ = (UNIT) & 255, h_ = bh_ & 3, m0_ = (bh_ >> 2) * SEQ + n_ * 64; gates_load(a, m0_, h_, tid, gin); \
        _Pragma("unroll") for (int s2 = 0; s2 < 2; ++s2) { const int c = tid + 512 * s2; const bf16* rp = proj + (size_t)(m0_ + (c >> 4)) * NIN + h_ * 128 + 8 * (c & 15); qreg[s2] = *(const v4u*)(rp + C_Q); kreg[s2] = *(const v4u*)(rp + C_K); } \
        _Pragma("unroll") for (int s4 = 0; s4 < 4; ++s4) { const int c = tid + 512 * s4; const bf16* rp = proj + (size_t)(m0_ + (c >> 5)) * NIN + h_ * 256 + 8 * (c & 31); vreg[s4] = *(const v4u*)(rp + C_V); rreg[s4] = *(const v4u*)(rp + C_R); } } while (0)
    if ((int)blockIdx.x < 2048) G3_LOADS((int)blockIdx.x);
    for (int unit = blockIdx.x; unit < 2048; unit += gridDim.x) {
        const int bh = unit >> 8, n = unit & 255, b = bh >> 2, h = bh & 3, m0 = b * SEQ + n * 64;
        float bq[16], blast;
        const bf16* Su = S + (size_t)unit * 32768;
        bf16x8 sf[4][2];
#pragma unroll
        for (int ks = 0; ks < 4; ++ks)
#pragma unroll
            for (int nt = 0; nt < 2; ++nt) sf[ks][nt] = *(const bf16x8*)(Su + (32 * wave + 16 * nt + r16) * 128 + 32 * ks + 8 * q4);
        gates_compute(gin, aL, tot, tid, bq, blast);
#pragma unroll
        for (int s2 = 0; s2 < 2; ++s2) { const int c = tid + 512 * s2; *(LAS v4u*)(Qs + (c >> 4) * 136 + 8 * (c & 15)) = qreg[s2]; *(LAS v4u*)(Ks + (c >> 4) * 136 + 8 * (c & 15)) = kreg[s2]; }
#pragma unroll
        for (int s4 = 0; s4 < 4; ++s4) { const int c = tid + 512 * s4; *(LAS v4u*)(Vs + (c >> 5) * 264 + 8 * (c & 31)) = vreg[s4]; *(LAS v4u*)(Rs + (c >> 5) * 264 + 8 * (c & 31)) = rreg[s4]; }
        { const int nu = unit + (int)gridDim.x; if (nu < 2048) G3_LOADS(nu); }
        __syncthreads();
#pragma unroll
        for (int ii = 0; ii < 16; ++ii) { const int i = 16 * ig + ii;
            const float qv = bf1(Qs[i * 136 + d]), kv = bf1(Ks[i * 136 + d]);
            Qs[i * 136 + d] = (bf16)(pk2(qv * 0.08838834764831845f * __expf(bq[ii]), 0.f) & 0xffffu);
            Ks[i * 136 + d] = (bf16)(pk2(kv * __expf(-bq[ii]), 0.f) & 0xffffu); }
        bf16x8 vf[2][2];
#pragma unroll
        for (int nt = 0; nt < 2; ++nt)
#pragma unroll
            for (int ks = 0; ks < 2; ++ks)
#pragma unroll
                for (int jj = 0; jj < 8; ++jj) vf[nt][ks][jj] = (short)Vs[(32 * ks + 8 * q4 + jj) * 264 + 32 * wave + 16 * nt + r16];
        __syncthreads();
#pragma unroll
        for (int tt = 0; tt < 2; ++tt) { const int t = 2 * wave + tt, it = t >> 2, jt = t & 3;
            f32x4 sc = (f32x4){0.f, 0.f, 0.f, 0.f};
            if (jt <= it) {
#pragma unroll
                for (int ks = 0; ks < 4; ++ks) { const bf16x8 af = *(const LAS bf16x8*)(Qs + (16 * it + r16) * 136 + 32 * ks + 8 * q4); const bf16x8 bf = *(const LAS bf16x8*)(Ks + (16 * jt + r16) * 136 + 32 * ks + 8 * q4);
                    sc = __builtin_amdgcn_mfma_f32_16x16x32_bf16(af, bf, sc, 0, 0, 0); } }
#pragma unroll
            for (int x = 0; x < 4; ++x) { const int i = 16 * it + 4 * q4 + x, j = 16 * jt + r16; Ps[i * 72 + j] = (bf16)(pk2(j <= i ? sc[x] : 0.f, 0.f) & 0xffffu); } }
        __syncthreads();
        f32x4 acc[4][2];
#pragma unroll
        for (int mt = 0; mt < 4; ++mt)
#pragma unroll
            for (int nt = 0; nt < 2; ++nt) acc[mt][nt] = (f32x4){0.f, 0.f, 0.f, 0.f};
#pragma unroll
        for (int ks = 0; ks < 2; ++ks)
#pragma unroll
            for (int mt = 0; mt < 4; ++mt) { const bf16x8 af = *(const LAS bf16x8*)(Ps + (16 * mt + r16) * 72 + 32 * ks + 8 * q4);
#pragma unroll
                for (int nt = 0; nt < 2; ++nt) acc[mt][nt] = __builtin_amdgcn_mfma_f32_16x16x32_bf16(af, vf[nt][ks], acc[mt][nt], 0, 0, 0); }
#pragma unroll
        for (int ks = 0; ks < 4; ++ks) {
#pragma unroll
            for (int mt = 0; mt < 4; ++mt) { const bf16x8 af = *(const LAS bf16x8*)(Qs + (16 * mt + r16) * 136 + 32 * ks + 8 * q4);
#pragma unroll
                for (int nt = 0; nt < 2; ++nt) acc[mt][nt] = __builtin_amdgcn_mfma_f32_16x16x32_bf16(af, sf[ks][nt], acc[mt][nt], 0, 0, 0); } }
#pragma unroll
        for (int mt = 0; mt < 4; ++mt)
#pragma unroll
            for (int x = 0; x < 4; ++x) { float ss = acc[mt][0][x] * acc[mt][0][x] + acc[mt][1][x] * acc[mt][1][x];
                ss += __shfl_xor(ss, 1); ss += __shfl_xor(ss, 2); ss += __shfl_xor(ss, 4); ss += __shfl_xor(ss, 8);
                if (r16 == 0) part[wave * 64 + 16 * mt + 4 * q4 + x] = ss; }
        __syncthreads();
        if (tid < 64) { float s = 0.f;
#pragma unroll
            for (int w = 0; w < 8; ++w) s += part[w * 64 + tid];
            rstdL[tid] = rsqrtf(s * (1.0f / 256.0f) + EPS); }
        __syncthreads();
#pragma unroll
        for (int nt = 0; nt < 2; ++nt) { const int e = 32 * wave + 16 * nt + r16; const float gw = a.in[I_GNW][e];
#pragma unroll
            for (int mt = 0; mt < 4; ++mt)
#pragma unroll
                for (int x = 0; x < 4; ++x) { const int i = 16 * mt + 4 * q4 + x; const float rr = bf1(Rs[i * 264 + e]);
                    const float y = acc[mt][nt][x] * rstdL[i] * gw * silu_f(rr);
                    Rs[i * 264 + e] = (bf16)(pk2(y, 0.f) & 0xffffu); } }
        __syncthreads();
#pragma unroll
        for (int s4 = 0; s4 < 4; ++s4) { const int c = tid + 512 * s4; *(v4u*)(Y + (size_t)(m0 + (c >> 5)) * D + 1024 + h * 256 + 8 * (c & 31)) = *(const LAS v4u*)(Rs + (c >> 5) * 264 + 8 * (c & 31)); }
        __syncthreads();
    }
}

#undef G3_LOADS
__device__ __forceinline__ void phase_mid(const Args& a, int lane, int wave) {
    const float* mod = (const float*)(a.ws + WS_MOD); bf16* H = (bf16*)(a.ws + WS_H); const bf16* Yb = (const bf16*)(a.ws + WS_Y);
    const int NGW = gridDim.x * NWAVES;
    for (int rb = blockIdx.x * NWAVES + wave; rb < M / 16; rb += NGW) {
        const int m0 = rb * 16, b = m0 >> 14; const float* mb = mod + b * 12288;
        float G[4][8], A[4][8], B[4][8];
#pragma unroll
        for (int j = 0; j < 4; ++j)
#pragma unroll
            for (int e = 0; e < 8; ++e) { const int col = 512 * j + 8 * lane + e; G[j][e] = mb[4096 + col] * a.in[I_MIXPOST][col];
                A[j][e] = a.in[I_FPRE][col] * (1.0f + mb[8192 + col]); B[j][e] = mb[6144 + col]; }
        for (int r = 0; r < 16; ++r) {
            const size_t ro = (size_t)(m0 + r) * D + 8 * lane;
            float y[4][8]; float ss = 0.f;
#pragma unroll
            for (int j = 0; j < 4; ++j) { unpack8(*(const v4u*)(Yb + ro + 512 * j), y[j]);
#pragma unroll
                for (int e = 0; e < 8; ++e) ss += y[j][e] * y[j][e]; }
            const float rstd = rsqrtf(wave_sum(ss) * (1.0f / D) + EPS);
            float s2 = 0.f;
#pragma unroll
            for (int j = 0; j < 4; ++j) { const f32x4 xa = *(const f32x4*)(a.in[I_X] + ro + 512 * j), xb = *(const f32x4*)(a.in[I_X] + ro + 512 * j + 4);
#pragma unroll
                for (int e = 0; e < 8; ++e) { const float xv = (e < 4 ? xa[e & 3] : xb[e & 3]) + G[j][e] * (y[j][e] * rstd); y[j][e] = xv; s2 += xv * xv; }
                *(f32x4*)(a.out + ro + 512 * j) = (f32x4){y[j][0], y[j][1], y[j][2], y[j][3]}; *(f32x4*)(a.out + ro + 512 * j + 4) = (f32x4){y[j][4], y[j][5], y[j][6], y[j][7]}; }
            const float rstd2 = rsqrtf(wave_sum(s2) * (1.0f / D) + EPS);
#pragma unroll
            for (int j = 0; j < 4; ++j) { float o[8];
#pragma unroll
                for (int e = 0; e < 8; ++e) o[e] = y[j][e] * rstd2 * A[j][e] + B[j][e];
                *(v4u*)(H + ro + 512 * j) = pack8(o); }
        }
    }
}

__device__ __forceinline__ void phase_fixup(const Args& a, int tid) {
    const bf16* HALO = (const bf16*)(a.ws + WS_HALO); bf16* ACT = (bf16*)(a.ws + WS_ACT); const float* cw = a.in[I_FCONVW];
    const int total = gridDim.x * NT;
    for (int item = blockIdx.x * NT + tid; item < 512 * 2 * 704; item += total) {
        const int cg = item % 704, gl = item / 704, lr = gl & 1, G = gl >> 1, j0 = 8 * cg, uc = 256 * (j0 >> 7) + (j0 & 127);
        const bool first = (G & 255) == 0;
        const bf16* hc = HALO + ((size_t)G * 4 + lr) * NUP + uc;
        const bf16* h1 = lr == 0 ? HALO + ((size_t)(G - 1) * 4 + 3) * NUP + uc : HALO + ((size_t)G * 4 + 0) * NUP + uc;
        const bf16* h2 = lr == 0 ? HALO + ((size_t)(G - 1) * 4 + 2) * NUP + uc : HALO + ((size_t)(G - 1) * 4 + 3) * NUP + uc;
        float g0[8], v0[8], g1[8], v1[8], g2[8], v2[8], o[8];
        unpack8(*(const v4u*)hc, g0); unpack8(*(const v4u*)(hc + 128), v0);
#pragma unroll
        for (int e = 0; e < 8; ++e) { g1[e] = 0.f; v1[e] = 0.f; g2[e] = 0.f; v2[e] = 0.f; }
        if (!(first && lr == 0)) { unpack8(*(const v4u*)h1, g1); unpack8(*(const v4u*)(h1 + 128), v1); }
        if (!first) { unpack8(*(const v4u*)h2, g2); unpack8(*(const v4u*)(h2 + 128), v2); }
#pragma unroll
        for (int e = 0; e < 8; ++e) { const float gg = cw[j0 + e] * g2[e] + cw[NUP + j0 + e] * g1[e] + cw[2 * NUP + j0 + e] * g0[e];
            const float vv = cw[DFF + j0 + e] * v2[e] + cw[NUP + DFF + j0 + e] * v1[e] + cw[2 * NUP + DFF + j0 + e] * v0[e];
            o[e] = silu_f(gg) * vv; }
        *(v4u*)(ACT + (size_t)(G * 64 + lr) * DFF + j0) = pack8(o);
    }
}

__device__ __forceinline__ void phase_final(const Args& a, int lane, int wave) {
    const float* mod = (const float*)(a.ws + WS_MOD); const bf16* Yb = (const bf16*)(a.ws + WS_Y2);
    const int NGW = gridDim.x * NWAVES;
    for (int rb = blockIdx.x * NWAVES + wave; rb < M / 16; rb += NGW) {
        const int m0 = rb * 16, b = m0 >> 14; const float* mb = mod + b * 12288;
        float G[4][8];
#pragma unroll
        for (int j = 0; j < 4; ++j)
#pragma unroll
            for (int e = 0; e < 8; ++e) { const int col = 512 * j + 8 * lane + e; G[j][e] = mb[10240 + col] * a.in[I_FPOST][col]; }
        for (int r = 0; r < 16; ++r) {
            const size_t ro = (size_t)(m0 + r) * D + 8 * lane;
            float y[4][8]; float ss = 0.f;
#pragma unroll
            for (int j = 0; j < 4; ++j) { unpack8(*(const v4u*)(Yb + ro + 512 * j), y[j]);
#pragma unroll
                for (int e = 0; e < 8; ++e) ss += y[j][e] * y[j][e]; }
            const float rstd = rsqrtf(wave_sum(ss) * (1.0f / D) + EPS);
#pragma unroll
            for (int j = 0; j < 4; ++j) { f32x4 xa = *(const f32x4*)(a.out + ro + 512 * j), xb = *(const f32x4*)(a.out + ro + 512 * j + 4);
#pragma unroll
                for (int e = 0; e < 4; ++e) { xa[e] += G[j][e] * (y[j][e] * rstd); xb[e] += G[j][e + 4] * (y[j][e + 4] * rstd); }
                *(f32x4*)(a.out + ro + 512 * j) = xa; *(f32x4*)(a.out + ro + 512 * j + 4) = xb; }
        }
    }
}

#define RLX_AGENT __ATOMIC_RELAXED, __HIP_MEMORY_SCOPE_AGENT
#define XB_TMO      128
#define XB_XCNT(j)  (256  + 64 * (j))
#define XB_XSUB(j)  (1280 + 64 * (j))
#define XB_XGEN(j)  (2304 + 64 * (j))
#define XB_TOP      3328
#define XB_TOPGEN   3392
#define XCD_BAR_WORDS 3456
#define XB_SPIN_CAP (1u << 18)

__device__ __forceinline__ unsigned xb_ld(unsigned* p)              { return __hip_atomic_load(p, __ATOMIC_RELAXED, __HIP_MEMORY_SCOPE_AGENT); }
__device__ __forceinline__ unsigned xb_add(unsigned* p, unsigned v) { return __hip_atomic_fetch_add(p, v, __ATOMIC_RELAXED, __HIP_MEMORY_SCOPE_AGENT); }
__device__ __forceinline__ unsigned xb_xcc_id() { return (unsigned)__builtin_amdgcn_s_getreg((3 << 11) | 20) & 0xFu; }
#define XB_SPIN(cond, bar) do { unsigned _sp = 0; while (cond) { __builtin_amdgcn_s_sleep(1); \
    if ((++_sp & 255u) == 0u) { if (xb_ld(&(bar)[XB_TMO])) break; if (_sp > XB_SPIN_CAP) { atomicAdd(&(bar)[XB_TMO], 1u); break; } } } } while (0)

struct XcdBarrier {
    unsigned* bar; unsigned x;
    volatile LAS unsigned* st;
};

__device__ __forceinline__ XcdBarrier xcd_barrier_post(unsigned* bar, volatile LAS unsigned* st) {
    XcdBarrier b; b.bar = bar; b.x = xb_xcc_id(); b.st = st;
    if (threadIdx.x == 0) (void)xb_add(&bar[XB_XCNT(b.x)], 1u);
    return b;
}
__device__ __forceinline__ void xcd_barrier_complete(unsigned* bar, unsigned x, unsigned& nloc, unsigned& nx) {
    const unsigned G = gridDim.x * gridDim.y * gridDim.z;
    unsigned sum, cnt, mine, sp = 0u;
    for (;;) {
        sum = 0u; cnt = 0u; mine = 0u;
#pragma unroll
        for (unsigned j = 0; j < 16; ++j) { const unsigned c = xb_ld(&bar[XB_XCNT(j)]); sum += c; cnt += (c > 0u) ? 1u : 0u; mine = (j == x) ? c : mine; }
        if (sum == G) break;
        __builtin_amdgcn_s_sleep(1);
        if ((++sp & 255u) == 0u) { if (xb_ld(&bar[XB_TMO])) break; if (sp > XB_SPIN_CAP) { atomicAdd(&bar[XB_TMO], 1u); break; } }
    }
    nloc = mine > 0u ? mine : 1u; nx = cnt > 0u ? cnt : 1u;
}

__device__ __forceinline__ void xcd_barrier(const XcdBarrier& b) {
    asm volatile("s_waitcnt vmcnt(0)" ::: "memory");
    __syncthreads();
    if (threadIdx.x == 0) {
        unsigned* bar = b.bar;
        __builtin_amdgcn_s_waitcnt(0);
        unsigned nloc = b.st[0], nx = b.st[1];
        if (nloc == 0u) { xcd_barrier_complete(bar, b.x, nloc, nx); b.st[0] = nloc; b.st[1] = nx; }
        const unsigned old = xb_add(&bar[XB_XSUB(b.x)], 1u);
        const unsigned gen = old / nloc;
        if (old + 1u == (gen + 1u) * nloc) {
            __builtin_amdgcn_fence(__ATOMIC_RELEASE, "agent");
            asm volatile("s_waitcnt vmcnt(0)" ::: "memory");
            const unsigned og = xb_add(&bar[XB_TOP], 1u);
            const unsigned tg = og / nx;
            if (og + 1u == (tg + 1u) * nx) xb_add(&bar[XB_TOPGEN], 1u);
            else XB_SPIN(xb_ld(&bar[XB_TOPGEN]) == tg, bar);
            __builtin_amdgcn_fence(__ATOMIC_ACQUIRE, "agent");
            xb_add(&bar[XB_XGEN(b.x)], 1u);
            asm volatile("s_waitcnt vmcnt(0)" ::: "memory");
        } else {
            XB_SPIN(xb_ld(&bar[XB_XGEN(b.x)]) == gen, bar);
            __builtin_amdgcn_fence(__ATOMIC_ACQUIRE, "agent");
            asm volatile("s_waitcnt vmcnt(0)" ::: "memory");
        }
    }
    __syncthreads();
}

constexpr int N_PHASES = 12;
#ifndef REP_GEMM
#define REP_GEMM 1
#endif
#ifndef REP_A
#define REP_A 1
#endif
#ifndef REP_B
#define REP_B 1
#endif
#ifndef REP_C
#define REP_C 1
#endif
__global__ void __launch_bounds__(NT, 2) fwd_kernel(Args args) {
    extern __shared__ __attribute__((aligned(16))) unsigned char lds_raw[];
    LAS unsigned char* lds = (LAS unsigned char*)lds_raw;
    const int tid = threadIdx.x, lane = tid & 63, wave = __builtin_amdgcn_readfirstlane(tid >> 6);
    const int lo = args.ph_lo, hi = args.ph_hi; unsigned char* ws = args.ws;
    volatile LAS unsigned* bst = (volatile LAS unsigned*)(lds + LDS_BYTES - 64);
    if (tid < 2) bst[tid] = 0u;
    __syncthreads();
    XcdBarrier xbar; xbar.bar = (unsigned*)ws; xbar.x = 0; xbar.st = nullptr;
    if (hi - lo > 1) xbar = xcd_barrier_post((unsigned*)ws, bst);
    if (lo < 0) cg::this_grid().sync();
#define IN(k) (lo <= (k) && (k) < hi)
#define SEAM(k) do { if (IN(k) && IN((k) + 1)) { xcd_barrier(xbar); } } while (0)
    if (IN(0)) { for (int rep = 0; rep < REP_A; ++rep) { phase_prologue(args, lds, tid, lane, wave); __syncthreads(); } } SEAM(0);
    if (IN(1)) { for (int rep = 0; rep < REP_A; ++rep) { phase_h1(args, lane, wave); __syncthreads(); } } SEAM(1);
    if (IN(2)) { pg8::Gemm g{(const bf16*)(ws + WS_H), (const bf16*)(ws + WS_WIN), M, NIN, D}; pg8::StaticOrder S; S.init(M, NIN, gridDim.x, blockIdx.x);
        pg8::EpiB16 E{(bf16*)(ws + WS_PROJ), NIN};
        _Pragma("unroll") for (int rep = 0; rep < REP_GEMM; ++rep) { pg8::gemm_phase<pg8::EpiB16, pg8::StaticOrder, true, true>(lds, g, S, E); __syncthreads(); } } SEAM(2);
    if (IN(3)) { for (int rep = 0; rep < REP_B; ++rep) { phase_g1(args, lds, tid, lane, wave); __syncthreads(); } } SEAM(3);
    if (IN(4)) { phase_g2(args, tid); } SEAM(4);
    if (IN(5)) { for (int rep = 0; rep < REP_B; ++rep) { phase_g3(args, lds, tid, lane, wave); __syncthreads(); } } SEAM(5);
    if (IN(6)) { pg8::Gemm g{(const bf16*)(ws + WS_H), (const bf16*)(ws + WS_WOUT), M, D, D}; pg8::StaticOrder S; S.init(M, D, gridDim.x, blockIdx.x);
        pg8::EpiB16 E{(bf16*)(ws + WS_Y), D};
        _Pragma("unroll") for (int rep = 0; rep < REP_GEMM; ++rep) { pg8::gemm_phase<pg8::EpiB16, pg8::StaticOrder, true, true>(lds, g, S, E); __syncthreads(); } } SEAM(6);
    if (IN(7)) { for (int rep = 0; rep < REP_A; ++rep) { phase_mid(args, lane, wave); __syncthreads(); } } SEAM(7);
    if (IN(8)) { pg8::Gemm g{(const bf16*)(ws + WS_H), (const bf16*)(ws + WS_WUP), M, NUP, D}; pg8::StaticOrder S; S.init(M, NUP, gridDim.x, blockIdx.x);
        pg8::EpiConvGate E{(bf16*)(ws + WS_ACT), (bf16*)(ws + WS_HALO), args.in[I_FCONVW]};
        _Pragma("unroll") for (int rep = 0; rep < REP_GEMM; ++rep) { pg8::gemm_phase<pg8::EpiConvGate, pg8::StaticOrder, true, true>(lds, g, S, E); __syncthreads(); } } SEAM(8);
    if (IN(9)) { phase_fixup(args, tid); } SEAM(9);
    if (IN(10)) { pg8::Gemm g{(const bf16*)(ws + WS_ACT), (const bf16*)(ws + WS_WDN), M, D, DFF}; pg8::StaticOrder S; S.init(M, D, gridDim.x, blockIdx.x);
        pg8::EpiB16 E{(bf16*)(ws + WS_Y2), D};
        _Pragma("unroll") for (int rep = 0; rep < REP_GEMM; ++rep) { pg8::gemm_phase<pg8::EpiB16, pg8::StaticOrder, true, true>(lds, g, S, E); __syncthreads(); } } SEAM(10);
    if (IN(11)) { phase_final(args, lane, wave); }
#undef IN
#undef SEAM
}

#ifndef N_LAUNCH_MODE
#define N_LAUNCH_MODE 1
#endif
extern "C" void kernel_launch(void* const* d_in, const int* in_sizes, int n_in, void* d_out, int out_size, void* d_ws, size_t ws_size, hipStream_t stream) {
    static int grid = 0;
    if (grid == 0) {
        if (n_in != 17 || out_size != M * D || ws_size < WS_END) { fprintf(stderr, "kernel_launch: unexpected shapes (n_in %d out %d ws %zu)\n", n_in, out_size, ws_size); grid = -1; return; }
        int dev = 0, cus = 0, per_cu = 0;
        hipGetDevice(&dev); hipDeviceGetAttribute(&cus, hipDeviceAttributeMultiprocessorCount, dev);
        hipFuncSetAttribute((const void*)fwd_kernel, hipFuncAttributeMaxDynamicSharedMemorySize, LDS_BYTES);
        hipOccupancyMaxActiveBlocksPerMultiprocessor(&per_cu, (const void*)fwd_kernel, NT, LDS_BYTES);
        if (per_cu < 1) { fprintf(stderr, "kernel_launch: occupancy query says %d blocks per CU\n", per_cu); per_cu = 1; }
        (void)hipGetLastError();
        grid = cus * per_cu;
        fprintf(stderr, "kernel_launch: grid %d (cus %d x %d)\n", grid, cus, per_cu);
    }
    if (grid < 0) return;
    Args a{};
    for (int i = 0; i < 17; ++i) a.in[i] = (const float*)d_in[i];
    a.out = (float*)d_out; a.ws = (unsigned char*)d_ws;
#if N_LAUNCH_MODE == 1
    a.ph_lo = 0; a.ph_hi = N_PHASES;
    (void)hipMemsetAsync(d_ws, 0, 16384, stream);
    void* kargs[] = {&a};
    hipError_t e = hipLaunchCooperativeKernel((const void*)fwd_kernel, dim3(grid), dim3(NT), kargs, LDS_BYTES, stream);
    if (e != hipSuccess) fprintf(stderr, "cooperative launch failed: %s (grid %d)\n", hipGetErrorString(e), grid);
#else
    for (int p = 0; p < N_PHASES; ++p) { a.ph_lo = p; a.ph_hi = p + 1; hipLaunchKernelGGL(fwd_kernel, dim3(grid), dim3(NT), LDS_BYTES, stream, a); }
#endif
}
```

```cpp
#include <hip/hip_runtime.h>
#include <hip/hip_cooperative_groups.h>
#include <cstdio>
#include <cstdint>
namespace cg = cooperative_groups;
namespace pg8 {
#define PG8_LAS __attribute__((address_space(3)))
typedef unsigned short bf16_t;
typedef short bf16x8 __attribute__((ext_vector_type(8)));
typedef float f32x4 __attribute__((ext_vector_type(4)));
typedef unsigned u32x4 __attribute__((ext_vector_type(4)));
typedef unsigned u32x2 __attribute__((ext_vector_type(2)));
typedef float f32x2 __attribute__((ext_vector_type(2)));
constexpr int BM = 256, BK = 64, HALF = 128, HTB = HALF * BK * 2  , STAGE_BYTES = 8 * HTB, NXCD = 8, WGM = 8;

__host__ __device__ __forceinline__ int lds_byte(int r, int c) { const int st = (r >> 4) * 2 + (c >> 5), rr = r & 15, cc = c & 31, ob = rr * 64 + cc * 2; return st * 1024 + (ob ^ (((ob >> 9) & 1) << 5)); }
__host__ __device__ __forceinline__ void stage_rc(int b, int& R, int& C) { const int st = b / 1024, sb = b % 1024, swz = sb ^ (((sb >> 9) & 1) << 5); R = (st >> 1) * 16 + swz / 64; C = (st & 1) * 32 + (swz % 64) / 2; }
__host__ __device__ __forceinline__ int perm32(int rho) { const int n = rho >> 4, i = rho & 15; return 8 * (i >> 2) + 4 * n + (i & 3); }

struct Unit { int pm, pn; };
struct Gemm { const bf16_t* A; const bf16_t* Bt; int M, N, K; };

struct StaticOrder {
    int nM, nN, nwg, G, c;
    __host__ __device__ void init(int M, int N, int G_, int c_) { nM = M / BM; nN = N / BM; nwg = nM * nN; G = G_; c = c_; }
    __host__ __device__ bool next(int i, Unit& u) const {
        const long L = (long)i * G + c; if (L >= nwg) return false;
        int wgid = (int)L; { const int q = nwg / NXCD, r = nwg % NXCD, xcd = wgid % NXCD, off = wgid / NXCD; wgid = (xcd < r ? xcd * (q + 1) : r * (q + 1) + (xcd - r) * q) + off; }
        const int nig = WGM * nN, gid = wgid / nig, fm = gid * WGM, gsz = (nM - fm) < WGM ? (nM - fm) : WGM;
        u.pm = fm + ((wgid % nig) % gsz); u.pn = (wgid % nig) / gsz; return true;
    }
    __device__ __forceinline__ void a_ready(const Unit&) const {}
    __device__ __forceinline__ void done(const Unit&) const {}
};

__device__ __forceinline__ unsigned cvt_pk_bf16(float lo, float hi) { unsigned r; asm volatile("v_cvt_pk_bf16_f32 %0, %1, %2" : "=v"(r) : "v"(lo), "v"(hi)); return r; }
typedef float cvt_f32x2_t __attribute__((ext_vector_type(2))); typedef __bf16 cvt_bf16x2_t __attribute__((ext_vector_type(2)));
__device__ __forceinline__ unsigned cvt_pk_bf16_safe(float lo, float hi) { cvt_f32x2_t v = {lo, hi}; cvt_bf16x2_t b = __builtin_convertvector(v, cvt_bf16x2_t); return __builtin_bit_cast(unsigned, b); }
#define PG8_MFMA_SETTLE() asm volatile("s_nop 7\n\ts_nop 7\n\ts_nop 7" ::: "memory")
struct EpiB16 {
    static constexpr bool PERM = true, AFTER_DRAIN = false;
    bf16_t* O; int ldc;
    __device__ __forceinline__ void operator()(const f32x4 (&acc)[2][2][4][2], const Unit& u, int wr, int wc, int fr, int fq) const {
        PG8_MFMA_SETTLE();
        const int row0 = u.pm * BM + wr * 64 + fr, col0 = u.pn * BM + wc * 32 + 8 * fq;
#pragma unroll
        for (int ai = 0; ai < 2; ++ai)
#pragma unroll
            for (int m = 0; m < 4; ++m) { bf16_t* rowp = O + (size_t)(row0 + ai * HALF + m * 16) * ldc + col0;
#pragma unroll
                for (int bj = 0; bj < 2; ++bj) { const f32x4 v0 = acc[ai][bj][m][0], v1 = acc[ai][bj][m][1];
                    u32x4 w; w.x = cvt_pk_bf16(v0[0], v0[1]); w.y = cvt_pk_bf16(v0[2], v0[3]); w.z = cvt_pk_bf16(v1[0], v1[1]); w.w = cvt_pk_bf16(v1[2], v1[3]);
                    *(u32x4*)(rowp + bj * HALF) = w; } }
    }
};
struct EpiProj {
    static constexpr bool PERM = true, AFTER_DRAIN = false;
    bf16_t* O; float* alr;
    __device__ __forceinline__ void operator()(const f32x4 (&acc)[2][2][4][2], const Unit& u, int wr, int wc, int fr, int fq) const {
        PG8_MFMA_SETTLE();
        const int row0 = u.pm * BM + wr * 64 + fr;
        if (u.pn < 24) {
            const int col0 = u.pn * BM + wc * 32 + 8 * fq;
#pragma unroll
            for (int ai = 0; ai < 2; ++ai)
#pragma unroll
                for (int m = 0; m < 4; ++m) { bf16_t* rowp = O + (size_t)(row0 + ai * HALF + m * 16) * 6144 + col0;
#pragma unroll
                    for (int bj = 0; bj < 2; ++bj) { const f32x4 v0 = acc[ai][bj][m][0], v1 = acc[ai][bj][m][1];
                        u32x4 w; w.x = cvt_pk_bf16(v0[0], v0[1]); w.y = cvt_pk_bf16(v0[2], v0[3]); w.z = cvt_pk_bf16(v1[0], v1[1]); w.w = cvt_pk_bf16(v1[2], v1[3]);
                        *(u32x4*)(rowp + bj * HALF) = w; } }
        } else if (wc == 0 && fq < 2) {
#pragma unroll
            for (int ai = 0; ai < 2; ++ai)
#pragma unroll
                for (int m = 0; m < 4; ++m) { float* rp = alr + (size_t)(row0 + ai * HALF + m * 16) * 16 + 8 * fq;
                    *(f32x4*)rp = acc[ai][0][m][0]; *(f32x4*)(rp + 4) = acc[ai][0][m][1]; }
        }
    }
};

template <int CTRL> __device__ __forceinline__ float dpp_ror(float v) { return __builtin_bit_cast(float, __builtin_amdgcn_update_dpp(0, __builtin_bit_cast(int, v), CTRL, 0xf, 0xf, false)); }
struct EpiConvGate {
    static constexpr bool PERM = true, AFTER_DRAIN = false;
    bf16_t* ACT; bf16_t* HALO; const float* cw;
    __device__ __forceinline__ void operator()(const f32x4 (&acc)[2][2][4][2], const Unit& u, int wr, int wc, int fr, int fq) const {
        PG8_MFMA_SETTLE();
        constexpr int NUPc = 11264, DFFc = 5632;
        const int j0 = u.pn * 128 + wc * 32 + 8 * fq;
        const int ucol = u.pn * BM + wc * 32 + 8 * fq;
        f32x4 wg[2][3], wv[2][3];
#pragma unroll
        for (int k = 0; k < 3; ++k) { wg[0][k] = *(const f32x4*)(cw + k * NUPc + j0); wv[0][k] = *(const f32x4*)(cw + k * NUPc + DFFc + j0); }
#pragma unroll
        for (int ai = 0; ai < 2; ++ai) {
            const int grp = u.pm * 4 + ai * 2 + wr;
            if (fr < 2 || fr >= 14) { const int rr = fr < 2 ? fr : fr - 12; bf16_t* hp = HALO + ((size_t)grp * 4 + rr) * NUPc + ucol;
#pragma unroll
                for (int bj = 0; bj < 2; ++bj) { const f32x4 v0 = fr < 2 ? acc[ai][bj][0][0] : acc[ai][bj][3][0], v1 = fr < 2 ? acc[ai][bj][0][1] : acc[ai][bj][3][1];
                    u32x4 w; w.x = cvt_pk_bf16(v0[0], v0[1]); w.y = cvt_pk_bf16(v0[2], v0[3]); w.z = cvt_pk_bf16(v1[0], v1[1]); w.w = cvt_pk_bf16(v1[2], v1[3]);
                    *(u32x4*)(hp + bj * HALF) = w; } }
        }
#pragma unroll
        for (int n = 0; n < 2; ++n) {
            if (n == 1) {
                asm volatile("" ::: "memory"); __builtin_amdgcn_sched_barrier(0);
#pragma unroll
                for (int k = 0; k < 3; ++k) { wg[1][k] = *(const f32x4*)(cw + k * NUPc + j0 + 4); wv[1][k] = *(const f32x4*)(cw + k * NUPc + DFFc + j0 + 4); } }
#pragma unroll
            for (int ai = 0; ai < 2; ++ai) {
                __builtin_amdgcn_sched_barrier(0);
                const int jc = j0 + 4 * n;
                f32x2 o[4][2];
#pragma unroll
                for (int xp = 0; xp < 2; ++xp) {
                    const f32x2 a0 = (f32x2){wg[n][0][2 * xp], wg[n][0][2 * xp + 1]}, a1 = (f32x2){wg[n][1][2 * xp], wg[n][1][2 * xp + 1]}, a2 = (f32x2){wg[n][2][2 * xp], wg[n][2][2 * xp + 1]};
                    const f32x2 b0 = (f32x2){wv[n][0][2 * xp], wv[n][0][2 * xp + 1]}, b1 = (f32x2){wv[n][1][2 * xp], wv[n][1][2 * xp + 1]}, b2 = (f32x2){wv[n][2][2 * xp], wv[n][2][2 * xp + 1]};
                    f32x2 g1p = (f32x2){0.f, 0.f}, g2p = g1p, v1p = g1p, v2p = g1p;
#pragma unroll
                    for (int m = 0; m < 4; ++m) {
                        const f32x2 g = (f32x2){acc[ai][0][m][n][2 * xp], acc[ai][0][m][n][2 * xp + 1]}, v = (f32x2){acc[ai][1][m][n][2 * xp], acc[ai][1][m][n][2 * xp + 1]};
                        f32x2 g1, g2, v1, v2, ga, gb, va, vb;
#pragma unroll
                        for (int c = 0; c < 2; ++c) { g1[c] = dpp_ror<0x121>(g[c]); g2[c] = dpp_ror<0x122>(g[c]); v1[c] = dpp_ror<0x121>(v[c]); v2[c] = dpp_ror<0x122>(v[c]);
                            ga[c] = fr == 0 ? g1p[c] : g1[c]; gb[c] = fr < 2 ? g2p[c] : g2[c]; va[c] = fr == 0 ? v1p[c] : v1[c]; vb[c] = fr < 2 ? v2p[c] : v2[c]; }
                        const f32x2 G = a0 * gb + a1 * ga + a2 * g, V = b0 * vb + b1 * va + b2 * v;
                        const f32x2 t = G * (-1.4426950408889634f);
                        f32x2 e; e.x = __builtin_amdgcn_exp2f(t.x); e.y = __builtin_amdgcn_exp2f(t.y);
                        const f32x2 dn = e + 1.0f;
                        f32x2 rc; rc.x = __builtin_amdgcn_rcpf(dn.x); rc.y = __builtin_amdgcn_rcpf(dn.y);
                        o[m][xp] = (G * rc) * V;
                        g1p = g1; g2p = g2; v1p = v1; v2p = v2;
                    }
                }
#pragma unroll
                for (int m = 0; m < 4; ++m) { const int row = u.pm * BM + ai * HALF + wr * 64 + m * 16 + fr;
                    u32x2 w; w.x = cvt_pk_bf16(o[m][0].x, o[m][0].y); w.y = cvt_pk_bf16(o[m][1].x, o[m][1].y);
                    if (m > 0 || fr >= 2) *(u32x2*)(ACT + (size_t)row * DFFc + jc) = w; }
            }
        }
    }
};

template <class Epi, class Sched, bool ALIGN_EPI = false, bool SP2 = false>
__device__ __forceinline__ void gemm_phase(PG8_LAS unsigned char* lds, const Gemm g, const Sched& S, const Epi& E) {
    const int tid = threadIdx.x, wid = __builtin_amdgcn_readfirstlane(tid >> 6), lane = tid & 63, wr = wid >> 2, wc = wid & 3, fr = lane & 15, fq = lane >> 4;
    const int K = g.K, nt = K / BK;
    unsigned voffA[2], voffB[2];
#pragma unroll
    for (int i = 0; i < 2; ++i) { int R, C; stage_rc(tid * 16 + i * 8192, R, C); const int Rb = Epi::PERM ? ((R & ~31) + perm32(R & 31)) : R;
        voffA[i] = (unsigned)(R * K + C) * 2u; voffB[i] = (unsigned)(Rb * K + C) * 2u; }
    const size_t kstep = (size_t)(BK * 2);
    const size_t hstep = (size_t)HALF * K * 2;
    const size_t tstep = 2 * hstep;
    const unsigned ldsw = (unsigned)wid * 1024u;
    const int aoff = lds_byte(wr * 64 + fr, fq * 8), boff = lds_byte(wc * 32 + fr, fq * 8);
#define PG8_SA(b, h) (((b) * 2 + (h)) * HTB)
#define PG8_SB(b, h) ((4 + (b) * 2 + (h)) * HTB)
#define PG8_STAGE(bufoff, gbase, voff) do { _Pragma("unroll") for (int _i = 0; _i < 2; ++_i) \
        __builtin_amdgcn_global_load_lds((const unsigned*)((const char*)(gbase) + (voff)[_i]), (PG8_LAS unsigned*)(lds + (bufoff) + ldsw + _i * 8192), 16, 0, 0); } while (0)
#define PG8_LDA(dst, b, h) do { _Pragma("unroll") for (int m = 0; m < 4; ++m) _Pragma("unroll") for (int k = 0; k < 2; ++k) dst[m][k] = *(const PG8_LAS bf16x8*)(lds + PG8_SA(b, h) + aoff + m * 2048 + k * 1024); } while (0)
#define PG8_LDB(dst, b, h) do { _Pragma("unroll") for (int n = 0; n < 2; ++n) _Pragma("unroll") for (int k = 0; k < 2; ++k) dst[n][k] = *(const PG8_LAS bf16x8*)(lds + PG8_SB(b, h) + boff + n * 2048 + k * 1024); } while (0)
#define PG8_MMA(ai, bj, At, Bt) do { __builtin_amdgcn_s_setprio(1); _Pragma("unroll") for (int m = 0; m < 4; ++m) _Pragma("unroll") for (int n = 0; n < 2; ++n) _Pragma("unroll") for (int k = 0; k < 2; ++k) \
        acc[ai][bj][m][n] = __builtin_amdgcn_mfma_f32_16x16x32_bf16(Bt[n][k], At[m][k], acc[ai][bj][m][n], 0, 0, 0); __builtin_amdgcn_s_setprio(0); } while (0)
#define PG8_WAIT_V(n) asm volatile("s_waitcnt vmcnt(" #n ")" ::: "memory")
#define PG8_WAIT_L(n) asm volatile("s_waitcnt lgkmcnt(" #n ")" ::: "memory")
#define PG8_BAR __builtin_amdgcn_s_barrier()
#define PG8_SCHED __builtin_amdgcn_sched_barrier(0)
    Unit cur, nxt; int ui = 0;
    if (!S.next(0, cur)) return;
    f32x4 acc[2][2][4][2];
#pragma unroll
    for (int a = 0; a < 2; ++a)
#pragma unroll
        for (int b = 0; b < 2; ++b)
#pragma unroll
            for (int m = 0; m < 4; ++m)
#pragma unroll
                for (int n = 0; n < 2; ++n) acc[a][b][m][n] = (f32x4){0.f, 0.f, 0.f, 0.f};
    bf16x8 At[4][2], B0[2][2], B1[2][2];
    const char* cA = (const char*)g.A + (size_t)cur.pm * tstep; const char* cB = (const char*)g.Bt + (size_t)cur.pn * tstep;
    S.a_ready(cur);
    if constexpr (SP2) {
        PG8_STAGE(PG8_SB(0, 0), cB, voffB); PG8_STAGE(PG8_SB(0, 1), cB + hstep, voffB); PG8_STAGE(PG8_SA(0, 0), cA, voffA); PG8_STAGE(PG8_SA(0, 1), cA + hstep, voffA);
        if (wr == 1) PG8_BAR;
        PG8_WAIT_V(2); PG8_BAR;
        PG8_STAGE(PG8_SB(1, 0), cB + kstep, voffB); PG8_STAGE(PG8_SA(1, 0), cA + kstep, voffA); PG8_STAGE(PG8_SB(1, 1), cB + hstep + kstep, voffB);
        PG8_WAIT_V(6); PG8_BAR;
    } else {
        PG8_STAGE(PG8_SB(0, 0), cB, voffB); PG8_STAGE(PG8_SA(0, 0), cA, voffA); PG8_STAGE(PG8_SB(0, 1), cB + hstep, voffB); PG8_STAGE(PG8_SA(0, 1), cA + hstep, voffA);
        if (wr == 1) PG8_BAR;
        PG8_WAIT_V(4); PG8_BAR;
        PG8_STAGE(PG8_SB(1, 0), cB + kstep, voffB); PG8_STAGE(PG8_SA(1, 0), cA + kstep, voffA); PG8_STAGE(PG8_SB(1, 1), cB + hstep + kstep, voffB);
        PG8_WAIT_V(6); PG8_BAR;
    }
    for (;;) {
        const bool has_next = S.next(ui + 1, nxt);
        const char* nA = has_next ? (const char*)g.A + (size_t)nxt.pm * tstep : cA; const char* nB = has_next ? (const char*)g.Bt + (size_t)nxt.pn * tstep : cB;
        for (int t = 0; t < nt; t += 2) {
            const bool last = (t == nt - 2);
            const char* a1 = cA + (size_t)(t + 1) * kstep;
            const char* a2 = last ? nA : cA + (size_t)(t + 2) * kstep; const char* b2 = last ? nB : cB + (size_t)(t + 2) * kstep;
            const char* a3 = a2 + kstep; const char* b3 = b2 + kstep;
            if (last && has_next) S.a_ready(nxt);
            if constexpr (SP2) {
            PG8_LDB(B0, 0, 0); PG8_LDB(B1, 0, 1); PG8_SCHED; PG8_LDA(At, 0, 0); PG8_STAGE(PG8_SA(1, 1), a1 + hstep, voffA);
            PG8_WAIT_V(8); PG8_WAIT_L(0); PG8_BAR; PG8_MMA(0, 0, At, B0); PG8_MMA(0, 1, At, B1); PG8_BAR; PG8_SCHED;
            PG8_LDA(At, 0, 1); PG8_STAGE(PG8_SB(0, 0), b2, voffB); PG8_STAGE(PG8_SB(0, 1), b2 + hstep, voffB); PG8_STAGE(PG8_SA(0, 0), a2, voffA);
            PG8_WAIT_V(8); PG8_WAIT_L(0); PG8_BAR; PG8_MMA(1, 0, At, B0); PG8_MMA(1, 1, At, B1); PG8_BAR; PG8_SCHED;
            PG8_LDB(B0, 1, 0); PG8_LDB(B1, 1, 1); PG8_SCHED; PG8_LDA(At, 1, 0); PG8_STAGE(PG8_SA(0, 1), a2 + hstep, voffA);
            PG8_WAIT_V(8); PG8_WAIT_L(0); PG8_BAR; PG8_MMA(0, 0, At, B0); PG8_MMA(0, 1, At, B1); PG8_BAR; PG8_SCHED;
            PG8_LDA(At, 1, 1); PG8_STAGE(PG8_SB(1, 0), b3, voffB); PG8_STAGE(PG8_SB(1, 1), b3 + hstep, voffB); PG8_STAGE(PG8_SA(1, 0), a3, voffA);
            PG8_WAIT_V(8); PG8_WAIT_L(0); PG8_BAR; PG8_MMA(1, 0, At, B0); PG8_MMA(1, 1, At, B1); PG8_BAR; PG8_SCHED;
            } else {
            PG8_LDB(B0, 0, 0); PG8_SCHED; PG8_LDA(At, 0, 0); PG8_STAGE(PG8_SA(1, 1), a1 + hstep, voffA);
            PG8_WAIT_L(8); PG8_BAR; PG8_WAIT_L(0); PG8_MMA(0, 0, At, B0); PG8_BAR; PG8_SCHED;
            PG8_LDB(B1, 0, 1); PG8_STAGE(PG8_SB(0, 0), b2, voffB);
            PG8_BAR; PG8_WAIT_L(0); PG8_MMA(0, 1, At, B1); PG8_BAR;
            PG8_LDA(At, 0, 1); PG8_STAGE(PG8_SA(0, 0), a2, voffA);
            PG8_BAR; PG8_WAIT_L(0); PG8_MMA(1, 0, At, B0); PG8_BAR; PG8_SCHED;
            PG8_STAGE(PG8_SB(0, 1), b2 + hstep, voffB);
            PG8_WAIT_V(6); PG8_BAR; PG8_MMA(1, 1, At, B1); PG8_BAR;
            PG8_LDB(B0, 1, 0); PG8_SCHED; PG8_LDA(At, 1, 0); PG8_STAGE(PG8_SA(0, 1), a2 + hstep, voffA);
            PG8_WAIT_L(8); PG8_BAR; PG8_WAIT_L(0); PG8_MMA(0, 0, At, B0); PG8_BAR; PG8_SCHED;
            PG8_LDB(B1, 1, 1); PG8_STAGE(PG8_SB(1, 0), b3, voffB);
            PG8_BAR; PG8_WAIT_L(0); PG8_MMA(0, 1, At, B1); PG8_BAR;
            PG8_LDA(At, 1, 1); PG8_STAGE(PG8_SA(1, 0), a3, voffA);
            PG8_BAR; PG8_WAIT_L(0); PG8_MMA(1, 0, At, B0); PG8_BAR; PG8_SCHED;
            PG8_STAGE(PG8_SB(1, 1), b3 + hstep, voffB);
            PG8_WAIT_V(6); PG8_BAR; PG8_MMA(1, 1, At, B1); PG8_BAR;
            }
        }
        if constexpr (ALIGN_EPI) { if (wr == 0) PG8_BAR; }
        if constexpr (!Epi::AFTER_DRAIN) { E(acc, cur, wr, wc, fr, fq); S.done(cur); }
        if (!has_next) break;
#pragma unroll
        for (int a = 0; a < 2; ++a)
#pragma unroll
            for (int b = 0; b < 2; ++b)
#pragma unroll
                for (int m = 0; m < 4; ++m)
#pragma unroll
                    for (int n = 0; n < 2; ++n) acc[a][b][m][n] = (f32x4){0.f, 0.f, 0.f, 0.f};
        cur = nxt; cA = nA; cB = nB; ++ui;
        if constexpr (ALIGN_EPI) { if (wr == 1) PG8_BAR; }
    }
    PG8_WAIT_V(0);
    if constexpr (!ALIGN_EPI) { if (wr == 0) PG8_BAR; }
    PG8_BAR;
    if constexpr (Epi::AFTER_DRAIN) { E.fused(acc, cur, wr, wc, fr, fq, lds, wid, lane); S.done(cur); }
#undef PG8_SA
#undef PG8_SB
#undef PG8_STAGE
#undef PG8_LDA
#undef PG8_LDB
#undef PG8_MMA
#undef PG8_WAIT_V
#undef PG8_WAIT_L
#undef PG8_BAR
#undef PG8_SCHED
}
}

constexpr int NWAVES = 8, NT = 512;
constexpr int SEQ = 16384, M = 32768, D = 2048, NIN = 6144, NINP = 6400, NIN_SRC = 6160, DFF = 5632, NUP = 11264, MH = 16384;
constexpr int C_CB = 0, C_CC = 1024, C_CX = 2048, C_Q = 3072, C_K = 3584, C_V = 4096, C_R = 5120;
constexpr float EPS = 1e-6f;
constexpr size_t MiB = 1u << 20;
constexpr size_t WS_MOD = 1 * MiB;
constexpr size_t WS_WIN = 2 * MiB, WS_WOUT = 27 * MiB, WS_WUP = 35 * MiB, WS_WDN = 79 * MiB;
constexpr size_t WS_H = 104 * MiB;
constexpr size_t WS_PROJ = 232 * MiB;
constexpr size_t WS_ALR = 616 * MiB;
constexpr size_t WS_S = 618 * MiB;
constexpr size_t WS_DEC = 746 * MiB;
constexpr size_t WS_Y = 360 * MiB;
constexpr size_t WS_RSTD = 488 * MiB;
constexpr size_t WS_HALO = 232 * MiB;
constexpr size_t WS_ACT = 584 * MiB;
constexpr size_t WS_Y2 = 232 * MiB;
constexpr size_t WS_END = 936 * MiB;
constexpr int LDS_BYTES = 147456;

#define GAS __attribute__((address_space(1)))
#define LAS __attribute__((address_space(3)))
typedef unsigned short bf16;
typedef unsigned v4u __attribute__((ext_vector_type(4)));
typedef unsigned v2u __attribute__((ext_vector_type(2)));
typedef float f32x4 __attribute__((ext_vector_type(4)));
typedef float f32x2 __attribute__((ext_vector_type(2)));
typedef short bf16x8 __attribute__((ext_vector_type(8)));
#define LDS_WAIT() asm volatile("s_waitcnt lgkmcnt(0)" ::: "memory")

__device__ __forceinline__ unsigned pk2(float lo, float hi) { return pg8::cvt_pk_bf16_safe(lo, hi); }
__device__ __forceinline__ float bflo(unsigned w) { return __uint_as_float(w << 16); }
__device__ __forceinline__ float bfhi(unsigned w) { return __uint_as_float(w & 0xffff0000u); }
__device__ __forceinline__ float bf1(bf16 b) { return __uint_as_float(((unsigned)b) << 16); }
__device__ __forceinline__ float silu_f(float v) { return v / (1.0f + __expf(-v)); }
__device__ __forceinline__ float wave_sum(float v) {
#pragma unroll
    for (int o = 1; o < 64; o <<= 1) v += __shfl_xor(v, o);
    return v;
}
__device__ __forceinline__ void unpack8(const v4u w, float (&f)[8]) {
    f[0] = bflo(w.x); f[1] = bfhi(w.x); f[2] = bflo(w.y); f[3] = bfhi(w.y); f[4] = bflo(w.z); f[5] = bfhi(w.z); f[6] = bflo(w.w); f[7] = bfhi(w.w);
}
__device__ __forceinline__ v4u pack8(const float (&f)[8]) { v4u w; w.x = pk2(f[0], f[1]); w.y = pk2(f[2], f[3]); w.z = pk2(f[4], f[5]); w.w = pk2(f[6], f[7]); return w; }

struct Args { const float* in[17]; float* out; unsigned char* ws; int ph_lo, ph_hi; };
enum { I_X = 0, I_C, I_WMOD, I_BMOD, I_MIXPRE, I_MIXPOST, I_WIN, I_CONVW, I_GW2, I_GB, I_GNW, I_WOUT, I_FPRE, I_FPOST, I_WUP, I_FCONVW, I_WDN };

__device__ __forceinline__ void transpose_item(const float* W, int K, int N, int k0, int n0, int ncols, bf16* WT, int drow0, LAS float* scr, int lane) {
    const int c4 = lane & 7, kr = lane >> 3; const bool cv = 4 * c4 < ncols;
    f32x4 wl[8];
#pragma unroll
    for (int i = 0; i < 8; ++i) wl[i] = cv ? *(const f32x4*)(W + (size_t)(k0 + 8 * i + kr) * N + n0 + 4 * c4) : (f32x4){0.f, 0.f, 0.f, 0.f};
#pragma unroll
    for (int i = 0; i < 8; ++i) { LAS float* sp = scr + (8 * i + kr) * 33 + 4 * c4; sp[0] = wl[i].x; sp[1] = wl[i].y; sp[2] = wl[i].z; sp[3] = wl[i].w; }
    LDS_WAIT(); asm volatile("" ::: "memory");
    const int c = lane & 7;
#pragma unroll
    for (int j = 0; j < 4; ++j) { const int n = (lane >> 3) + 8 * j; const LAS float* s = scr + (8 * c) * 33 + n;
        v4u o; o.x = pk2(s[0 * 33], s[1 * 33]); o.y = pk2(s[2 * 33], s[3 * 33]); o.z = pk2(s[4 * 33], s[5 * 33]); o.w = pk2(s[6 * 33], s[7 * 33]);
        if (n < ncols) *(v4u*)(WT + (size_t)(drow0 + n) * K + k0 + 8 * c) = o; }
    LDS_WAIT(); asm volatile("" ::: "memory");
}

__device__ __forceinline__ void phase_prologue(const Args& a, LAS unsigned char* lds, int tid, int lane, int wave) {
    unsigned char* ws = a.ws;
    if (blockIdx.x < 192) {
        LAS float* ca = (LAS float*)lds;
        LAS float* red = (LAS float*)(lds + 16384);
        const float* c = a.in[I_C];
        for (int i = tid; i < 4096; i += NT) ca[i] = silu_f(c[i]);
        __syncthreads();
        const int col = blockIdx.x * 64 + lane; const float* wm = a.in[I_WMOD] + col;
        float a0 = 0.f, a1 = 0.f;
        for (int k0 = wave * 256; k0 < wave * 256 + 256; k0 += 32) {
            float wv[32];
#pragma unroll
            for (int i = 0; i < 32; ++i) wv[i] = wm[(size_t)(k0 + i) * 12288];
#pragma unroll
            for (int i = 0; i < 32; ++i) { a0 += ca[k0 + i] * wv[i]; a1 += ca[2048 + k0 + i] * wv[i]; } }
        red[(wave * 2 + 0) * 64 + lane] = a0; red[(wave * 2 + 1) * 64 + lane] = a1;
        __syncthreads();
        if (tid < 128) { const int b = tid >> 6, l = tid & 63; float s = 0.f;
#pragma unroll
            for (int w = 0; w < 8; ++w) s += red[(w * 2 + b) * 64 + l];
            const int cc = blockIdx.x * 64 + l; ((float*)(ws + WS_MOD))[b * 12288 + cc] = s + a.in[I_BMOD][cc]; }
        __syncthreads();
    }
    LAS float* scr = (LAS float*)(lds + wave * 16384);
    const int gw = blockIdx.x * NWAVES + wave, NGW = gridDim.x * NWAVES;
    constexpr int IT_IN = 32 * 193, IT_OUT = 32 * 64, IT_UP = 32 * 352, IT_DN = 88 * 64;
    for (int it = gw; it < IT_IN + IT_OUT + IT_UP + IT_DN; it += NGW) {
        int r = it;
        if (r < IT_IN) { const int kb = r / 193, nb = r % 193; transpose_item(a.in[I_WIN], D, NIN_SRC, 64 * kb, 32 * nb, nb == 192 ? 16 : 32, (bf16*)(ws + WS_WIN), 32 * nb, scr, lane); continue; } r -= IT_IN;
        if (r < IT_OUT) { const int kb = r / 64, nb = r % 64; transpose_item(a.in[I_WOUT], D, D, 64 * kb, 32 * nb, 32, (bf16*)(ws + WS_WOUT), 32 * nb, scr, lane); continue; } r -= IT_OUT;
        if (r < IT_UP) { const int kb = r / 352, nb = r % 352; const int n0 = 32 * nb; const int jj = n0 < DFF ? n0 : n0 - DFF;
            const int drow = 256 * (jj >> 7) + (n0 < DFF ? 0 : 128) + (jj & 127);
            transpose_item(a.in[I_WUP], D, NUP, 64 * kb, n0, 32, (bf16*)(ws + WS_WUP), drow, scr, lane); continue; } r -= IT_UP;
        { const int kb = r / 64, nb = r % 64; transpose_item(a.in[I_WDN], DFF, D, 64 * kb, 32 * nb, 32, (bf16*)(ws + WS_WDN), 32 * nb, scr, lane); }
    }
}

__device__ __forceinline__ void phase_h1(const Args& a, int lane, int wave) {
    const float* mod = (const float*)(a.ws + WS_MOD); bf16* H = (bf16*)(a.ws + WS_H);
    const int NGW = gridDim.x * NWAVES;
    for (int rb = blockIdx.x * NWAVES + wave; rb < M / 16; rb += NGW) {
        const int m0 = rb * 16, b = m0 >> 14; const float* mb = mod + b * 12288;
        float A[4][8], B[4][8];
#pragma unroll
        for (int j = 0; j < 4; ++j)
#pragma unroll
            for (int e = 0; e < 8; ++e) { const int col = 512 * j + 8 * lane + e; A[j][e] = a.in[I_MIXPRE][col] * (1.0f + mb[2048 + col]); B[j][e] = mb[col]; }
        for (int r = 0; r < 16; ++r) {
            const float* xr = a.in[I_X] + (size_t)(m0 + r) * D + 8 * lane;
            f32x4 v[4][2]; float ss = 0.f;
#pragma unroll
            for (int j = 0; j < 4; ++j) { v[j][0] = *(const f32x4*)(xr + 512 * j); v[j][1] = *(const f32x4*)(xr + 512 * j + 4); }
#pragma unroll
            for (int j = 0; j < 4; ++j)
#pragma unroll
                for (int q = 0; q < 2; ++q) ss += (v[j][q].x * v[j][q].x + v[j][q].y * v[j][q].y) + (v[j][q].z * v[j][q].z + v[j][q].w * v[j][q].w);
            const float rstd = rsqrtf(wave_sum(ss) * (1.0f / D) + EPS);
            bf16* hr = H + (size_t)(m0 + r) * D + 8 * lane;
#pragma unroll
            for (int j = 0; j < 4; ++j) { float o[8];
#pragma unroll
                for (int e = 0; e < 8; ++e) o[e] = v[j][e >> 2][e & 3] * rstd * A[j][e] + B[j][e];
                *(v4u*)(hr + 512 * j) = pack8(o); }
        }
        asm volatile("s_waitcnt vmcnt(0)" ::: "memory");
        { const int r16 = lane & 15, q4 = lane >> 4;
          const bf16* hrow = H + (size_t)(m0 + r16) * D + 8 * q4; const bf16* wrow = (const bf16*)(a.ws + WS_WIN) + (size_t)(NIN + r16) * D + 8 * q4;
          f32x4 acc0 = (f32x4){0.f, 0.f, 0.f, 0.f}, acc1 = acc0;
          for (int ks = 0; ks < 64; ks += 8) {
              bf16x8 af[8], bf[8];
#pragma unroll
              for (int i = 0; i < 8; ++i) { af[i] = *(const bf16x8*)(hrow + 32 * (ks + i)); bf[i] = *(const bf16x8*)(wrow + 32 * (ks + i)); }
#pragma unroll
              for (int i = 0; i < 8; i += 2) { acc0 = __builtin_amdgcn_mfma_f32_16x16x32_bf16(af[i], bf[i], acc0, 0, 0, 0); acc1 = __builtin_amdgcn_mfma_f32_16x16x32_bf16(af[i + 1], bf[i + 1], acc1, 0, 0, 0); } }
          float* alr = (float*)(a.ws + WS_ALR);
#pragma unroll
          for (int x = 0; x < 4; ++x) alr[(size_t)(m0 + 4 * q4 + x) * 16 + r16] = acc0[x] + acc1[x]; }
    }
}

struct GateIn { f32x4 av; float w2r[16]; float gb; };
__device__ __forceinline__ void gates_load(const Args& a, int m0, int h, int tid, GateIn& g) {
    const float* alr = (const float*)(a.ws + WS_ALR) + (size_t)m0 * 16;
    g.av = (f32x4){0.f, 0.f, 0.f, 0.f};
    if (tid < 256) g.av = *(const f32x4*)(alr + 4 * tid);
    const int d = tid & 127;
#pragma unroll
    for (int r = 0; r < 16; ++r) g.w2r[r] = a.in[I_GW2][r * 512 + h * 128 + d];
    g.gb = a.in[I_GB][h * 128 + d];
}
__device__ __forceinline__ void gates_compute(const GateIn& g, LAS float* aL, LAS float* tot, int tid, float (&bq)[16], float& blast) {
    if (tid < 256) *(LAS f32x4*)(aL + 4 * tid) = g.av;
    const int d = tid & 127, ig = tid >> 7;
    __syncthreads();
    float run = 0.f;
#pragma unroll
    for (int ii = 0; ii < 16; ++ii) { const LAS f32x4* ar = (const LAS f32x4*)(aL + (16 * ig + ii) * 16); float z = g.gb;
#pragma unroll
        for (int r4 = 0; r4 < 4; ++r4) { const f32x4 av = ar[r4]; z += av.x * g.w2r[4 * r4] + av.y * g.w2r[4 * r4 + 1] + av.z * g.w2r[4 * r4 + 2] + av.w * g.w2r[4 * r4 + 3]; }
        const float ls = fminf(z, 0.f) - __logf(1.0f + __expf(-fabsf(z)));
        run += ls * (1.0f / 16.0f); bq[ii] = run; }
    tot[ig * 128 + d] = run;
    __syncthreads();
    float off = 0.f, all = 0.f;
#pragma unroll
    for (int gg = 0; gg < 4; ++gg) { const float t = tot[gg * 128 + d]; all += t; off += (gg < ig) ? t : 0.f; }
#pragma unroll
    for (int ii = 0; ii < 16; ++ii) bq[ii] += off;
    blast = all;
}

__device__ __forceinline__ void phase_g1(const Args& a, LAS unsigned char* lds, int tid, int lane, int wave) {
    LAS float* aL = (LAS float*)lds; LAS float* tot = (LAS float*)(lds + 4096); LAS bf16* kdT = (LAS bf16*)(lds + 8192);
    LAS bf16* Kr = (LAS bf16*)(lds + 26624); LAS bf16* Vs = (LAS bf16*)(lds + 44032);
    const bf16* proj = (const bf16*)(a.ws + WS_PROJ); bf16* S = (bf16*)(a.ws + WS_S); float* dec = (float*)(a.ws + WS_DEC);
    const int d = tid & 127, ig = tid >> 7, r16 = lane & 15, q4 = lane >> 4;
    GateIn gin; v4u kreg[2], vreg[4];
#define G1_LOADS(UNIT) do { const int bh_ = (UNIT) >> 8, n_ = (UNIT) & 255, h_ = bh_ & 3, m0_ = (bh_ >> 2) * SEQ + n_ * 64; gates_load(a, m0_, h_, tid, gin); \
        _Pragma("unroll") for (int s2 = 0; s2 < 2; ++s2) { const int c = tid + 512 * s2; kreg[s2] = *(const v4u*)(proj + (size_t)(m0_ + (c >> 4)) * NIN + C_K + h_ * 128 + 8 * (c & 15)); } \
        _Pragma("unroll") for (int s4 = 0; s4 < 4; ++s4) { const int c = tid + 512 * s4; vreg[s4] = *(const v4u*)(proj + (size_t)(m0_ + (c >> 5)) * NIN + C_V + h_ * 256 + 8 * (c & 31)); } } while (0)
    if ((int)blockIdx.x < 2048) G1_LOADS((int)blockIdx.x);
    for (int unit = blockIdx.x; unit < 2048; unit += gridDim.x) {
        const int bh = unit >> 8, n = unit & 255, b = bh >> 2, h = bh & 3, m0 = b * SEQ + n * 64;
        float bq[16], blast;
        gates_compute(gin, aL, tot, tid, bq, blast);
#pragma unroll
        for (int s2 = 0; s2 < 2; ++s2) { const int c = tid + 512 * s2; *(LAS v4u*)(Kr + (c >> 4) * 136 + 8 * (c & 15)) = kreg[s2]; }
#pragma unroll
        for (int s4 = 0; s4 < 4; ++s4) { const int c = tid + 512 * s4; *(LAS v4u*)(Vs + (c >> 5) * 264 + 8 * (c & 31)) = vreg[s4]; }
        { const int nu = unit + (int)gridDim.x; if (nu < 2048) G1_LOADS(nu); }
        __syncthreads();
        { float kd[16];
#pragma unroll
          for (int ii = 0; ii < 16; ++ii) kd[ii] = bf1(Kr[(16 * ig + ii) * 136 + d]) * __expf(blast - bq[ii]);
          v4u w0, w1; w0.x = pk2(kd[0], kd[1]); w0.y = pk2(kd[2], kd[3]); w0.z = pk2(kd[4], kd[5]); w0.w = pk2(kd[6], kd[7]);
          w1.x = pk2(kd[8], kd[9]); w1.y = pk2(kd[10], kd[11]); w1.z = pk2(kd[12], kd[13]); w1.w = pk2(kd[14], kd[15]);
          *(LAS v4u*)(kdT + d * 72 + 16 * ig) = w0; *(LAS v4u*)(kdT + d * 72 + 16 * ig + 8) = w1;
          if (ig == 0) dec[unit * 128 + d] = __expf(blast); }
        bf16x8 vf[2][2];
#pragma unroll
        for (int nt = 0; nt < 2; ++nt)
#pragma unroll
            for (int ks = 0; ks < 2; ++ks)
#pragma unroll
                for (int jj = 0; jj < 8; ++jj) vf[nt][ks][jj] = (short)Vs[(32 * ks + 8 * q4 + jj) * 264 + 32 * wave + 16 * nt + r16];
        __syncthreads();
        f32x4 acc[8][2];
#pragma unroll
        for (int mt = 0; mt < 8; ++mt)
#pragma unroll
            for (int nt = 0; nt < 2; ++nt) acc[mt][nt] = (f32x4){0.f, 0.f, 0.f, 0.f};
#pragma unroll
        for (int mt = 0; mt < 8; ++mt)
#pragma unroll
            for (int ks = 0; ks < 2; ++ks) { const bf16x8 af = *(const LAS bf16x8*)(kdT + (16 * mt + r16) * 72 + 32 * ks + 8 * q4);
#pragma unroll
                for (int nt = 0; nt < 2; ++nt) acc[mt][nt] = __builtin_amdgcn_mfma_f32_16x16x32_bf16(af, vf[nt][ks], acc[mt][nt], 0, 0, 0); }
        bf16* Su = S + (size_t)unit * 32768;
#pragma unroll
        for (int mt = 0; mt < 8; ++mt)
#pragma unroll
            for (int nt = 0; nt < 2; ++nt) { v2u w; w.x = pk2(acc[mt][nt][0], acc[mt][nt][1]); w.y = pk2(acc[mt][nt][2], acc[mt][nt][3]);
                *(v2u*)(Su + (32 * wave + 16 * nt + r16) * 128 + 16 * mt + 4 * q4) = w; }
        __syncthreads();
    }
#undef G1_LOADS
    bf16* Y = (bf16*)(a.ws + WS_H);
    for (int item = blockIdx.x; item < M / 64; item += gridDim.x) {
        const int c0 = 8 * (tid & 127), mr = item * 64 + 16 * (tid >> 7);
        float w0[8], w1[8], w2[8], p1[8], p2[8];
#pragma unroll
        for (int e = 0; e < 8; ++e) { w0[e] = a.in[I_CONVW][c0 + e]; w1[e] = a.in[I_CONVW][1024 + c0 + e]; w2[e] = a.in[I_CONVW][2048 + c0 + e]; p1[e] = 0.f; p2[e] = 0.f; }
        if ((mr & (SEQ - 1)) != 0) {
            float c1[8], x1[8]; const bf16* r2 = proj + (size_t)(mr - 2) * NIN + c0; const bf16* r1 = proj + (size_t)(mr - 1) * NIN + c0;
            unpack8(*(const v4u*)(r2 + C_CC), c1); unpack8(*(const v4u*)(r2 + C_CX), x1);
#pragma unroll
            for (int e = 0; e < 8; ++e) p2[e] = c1[e] * x1[e];
            unpack8(*(const v4u*)(r1 + C_CC), c1); unpack8(*(const v4u*)(r1 + C_CX), x1);
#pragma unroll
            for (int e = 0; e < 8; ++e) p1[e] = c1[e] * x1[e];
        }
        for (int r0 = 0; r0 < 16; r0 += 4) {
            v4u rb[4], rc[4], rx[4];
#pragma unroll
            for (int q = 0; q < 4; ++q) { const bf16* rp = proj + (size_t)(mr + r0 + q) * NIN + c0; rb[q] = *(const v4u*)(rp + C_CB); rc[q] = *(const v4u*)(rp + C_CC); rx[q] = *(const v4u*)(rp + C_CX); }
#pragma unroll
            for (int q = 0; q < 4; ++q) { float cb[8], cc[8], cx[8], o[8];
                unpack8(rb[q], cb); unpack8(rc[q], cc); unpack8(rx[q], cx);
#pragma unroll
                for (int e = 0; e < 8; ++e) { const float p0 = cc[e] * cx[e]; o[e] = cb[e] * (w0[e] * p2[e] + w1[e] * p1[e] + w2[e] * p0); p2[e] = p1[e]; p1[e] = p0; }
                *(v4u*)(Y + (size_t)(mr + r0 + q) * D + c0) = pack8(o); }
        }
    }
}

__device__ __forceinline__ void phase_g2(const Args& a, int tid) {
    unsigned* S = (unsigned*)(a.ws + WS_S); const float* dec = (const float*)(a.ws + WS_DEC);
    const int total = gridDim.x * NT;
    for (int idx = blockIdx.x * NT + tid; idx < 8 * 16384; idx += total) {
        const int bh = idx >> 14, r = idx & 16383, d0 = (2 * r) & 127;
        float s0 = 0.f, s1 = 0.f;
        for (int n0 = 0; n0 < 256; n0 += 16) {
            unsigned w[16]; f32x2 dd[16];
#pragma unroll
            for (int i = 0; i < 16; ++i) { const int unit = bh * 256 + n0 + i; w[i] = S[(size_t)unit * 16384 + r]; dd[i] = *(const f32x2*)(dec + unit * 128 + d0); }
#pragma unroll
            for (int i = 0; i < 16; ++i) { const int unit = bh * 256 + n0 + i; S[(size_t)unit * 16384 + r] = pk2(s0, s1);
                s0 = dd[i].x * s0 + bflo(w[i]); s1 = dd[i].y * s1 + bfhi(w[i]); }
        }
    }
}

__device__ __forceinline__ void phase_g3(const Args& a, LAS unsigned char* lds, int tid, int lane, int wave) {
    LAS float* aL = (LAS float*)lds; LAS float* tot = (LAS float*)(lds + 4096); LAS float* part = (LAS float*)(lds + 6144); LAS float* rstdL = (LAS float*)(lds + 8192);
    LAS bf16* Qs = (LAS bf16*)(lds + 8704); LAS bf16* Ks = (LAS bf16*)(lds + 8704 + 17408); LAS bf16* Ps = (LAS bf16*)(lds + 8704 + 2 * 17408);
    LAS bf16* Vs = (LAS bf16*)(lds + 52736); LAS bf16* Rs = (LAS bf16*)(lds + 86528);
    const bf16* proj = (const bf16*)(a.ws + WS_PROJ); const bf16* S = (const bf16*)(a.ws + WS_S); bf16* Y = (bf16*)(a.ws + WS_H);
    const int d = tid & 127, ig = tid >> 7, r16 = lane & 15, q4 = lane >> 4;
    GateIn gin; v4u qreg[2], kreg[2], vreg[4], rreg[4];
#define G3_LOADS(UNIT) do { const int bh_ = (UNIT) >> 8, n_ = (UNIT) & 255, h_ = bh_ & 3, m0_ = (bh_ >> 2) * SEQ + n_ * 64; gates_load(a, m0_, h_, tid, gin); \
        _Pragma("unroll") for (int s2 = 0; s2 < 2; ++s2) { const int c = tid + 512 * s2; const bf16* rp = proj + (size_t)(m0_ + (c >> 4)) * NIN + h_ * 128 + 8 * (c & 15); qreg[s2] = *(const v4u*)(rp + C_Q); kreg[s2] = *(const v4u*)(rp + C_K); } \
        _Pragma("unroll") for (int s4 = 0; s4 < 4; ++s4) { const int c = tid + 512 * s4; const bf16* rp = proj + (size_t)(m0_ + (c >> 5)) * NIN + h_ * 256 + 8 * (c & 31); vreg[s4] = *(const v4u*)(rp + C_V); rreg[s4] = *(const v4u*)(rp + C_R); } } while (0)
    if ((int)blockIdx.x < 2048) G3_LOADS((int)blockIdx.x);
    for (int unit = blockIdx.x; unit < 2048; unit += gridDim.x) {
        const int bh = unit >> 8, n = unit & 255, b = bh >> 2, h = bh & 3, m0 = b * SEQ + n * 64;
        float bq[16], blast;
        const bf16* Su = S + (size_t)unit * 32768;
        bf16x8 sf[4][2];
#pragma unroll
        for (int ks = 0; ks < 4; ++ks)
#pragma unroll
            for (int nt = 0; nt < 2; ++nt) sf[ks][nt] = *(const bf16x8*)(Su + (32 * wave + 16 * nt + r16) * 128 + 32 * ks + 8 * q4);
        gates_compute(gin, aL, tot, tid, bq, blast);
#pragma unroll
        for (int s2 = 0; s2 < 2; ++s2) { const int c = tid + 512 * s2; *(LAS v4u*)(Qs + (c >> 4) * 136 + 8 * (c & 15)) = qreg[s2]; *(LAS v4u*)(Ks + (c >> 4) * 136 + 8 * (c & 15)) = kreg[s2]; }
#pragma unroll
        for (int s4 = 0; s4 < 4; ++s4) { const int c = tid + 512 * s4; *(LAS v4u*)(Vs + (c >> 5) * 264 + 8 * (c & 31)) = vreg[s4]; *(LAS v4u*)(Rs + (c >> 5) * 264 + 8 * (c & 31)) = rreg[s4]; }
        { const int nu = unit + (int)gridDim.x; if (nu < 2048) G3_LOADS(nu); }
        __syncthreads();
#pragma unroll
        for (int ii = 0; ii < 16; ++ii) { const int i = 16 * ig + ii;
            const float qv = bf1(Qs[i * 136 + d]), kv = bf1(Ks[i * 136 + d]);
            Qs[i * 136 + d] = (bf16)(pk2(qv * 0.08838834764831845f * __expf(bq[ii]), 0.f) & 0xffffu);
            Ks[i * 136 + d] = (bf16)(pk2(kv * __expf(-bq[ii]), 0.f) & 0xffffu); }
        bf16x8 vf[2][2];
#pragma unroll
        for (int nt = 0; nt < 2; ++nt)
#pragma unroll
            for (int ks = 0; ks < 2; ++ks)
#pragma unroll
                for (int jj = 0; jj < 8; ++jj) vf[nt][ks][jj] = (short)Vs[(32 * ks + 8 * q4 + jj) * 264 + 32 * wave + 16 * nt + r16];
        __syncthreads();
#pragma unroll
        for (int tt = 0; tt < 2; ++tt) { const int t = 2 * wave + tt, it = t >> 2, jt = t & 3;
            f32x4 sc = (f32x4){0.f, 0.f, 0.f, 0.f};
            if (jt <= it) {
#pragma unroll
                for (int ks = 0; ks < 4; ++ks) { const bf16x8 af = *(const LAS bf16x8*)(Qs + (16 * it + r16) * 136 + 32 * ks + 8 * q4); const bf16x8 bf = *(const LAS bf16x8*)(Ks + (16 * jt + r16) * 136 + 32 * ks + 8 * q4);
                    sc = __builtin_amdgcn_mfma_f32_16x16x32_bf16(af, bf, sc, 0, 0, 0); } }
#pragma unroll
            for (int x = 0; x < 4; ++x) { const int i = 16 * it + 4 * q4 + x, j = 16 * jt + r16; Ps[i * 72 + j] = (bf16)(pk2(j <= i ? sc[x] : 0.f, 0.f) & 0xffffu); } }
        __syncthreads();
        f32x4 acc[4][2];
#pragma unroll
        for (int mt = 0; mt < 4; ++mt)
#pragma unroll
            for (int nt = 0; nt < 2; ++nt) acc[mt][nt] = (f32x4){0.f, 0.f, 0.f, 0.f};
#pragma unroll
        for (int ks = 0; ks < 2; ++ks)
#pragma unroll
            for (int mt = 0; mt < 4; ++mt) { const bf16x8 af = *(const LAS bf16x8*)(Ps + (16 * mt + r16) * 72 + 32 * ks + 8 * q4);
#pragma unroll
                for (int nt = 0; nt < 2; ++nt) acc[mt][nt] = __builtin_amdgcn_mfma_f32_16x16x32_bf16(af, vf[nt][ks], acc[mt][nt], 0, 0, 0); }
#pragma unroll
        for (int ks = 0; ks < 4; ++ks) {
#pragma unroll
            for (int mt = 0; mt < 4; ++mt) { const bf16x8 af = *(const LAS bf16x8*)(Qs + (16 * mt + r16) * 136 + 32 * ks + 8 * q4);
#pragma unroll
                for (int nt = 0; nt < 2; ++nt) acc[mt][nt] = __builtin_amdgcn_mfma_f32_16x16x32_bf16(af, sf[ks][nt], acc[mt][nt], 0, 0, 0); } }
#pragma unroll
        for (int mt = 0; mt < 4; ++mt)
#pragma unroll
            for (int x = 0; x < 4; ++x) { float ss = acc[mt][0][x] * acc[mt][0][x] + acc[mt][1][x] * acc[mt][1][x];
                ss += __shfl_xor(ss, 1); ss += __shfl_xor(ss, 2); ss += __shfl_xor(ss, 4); ss += __shfl_xor(ss, 8);
                if (r16 == 0) part[wave * 64 + 16 * mt + 4 * q4 + x] = ss; }
        __syncthreads();
        if (tid < 64) { float s = 0.f;
#pragma unroll
            for (int w = 0; w < 8; ++w) s += part[w * 64 + tid];
            rstdL[tid] = rsqrtf(s * (1.0f / 256.0f) + EPS); }
        __syncthreads();
#pragma unroll
        for (int nt = 0; nt < 2; ++nt) { const int e = 32 * wave + 16 * nt + r16; const float gw = a.in[I_GNW][e];
#pragma unroll
            for (int mt = 0; mt < 4; ++mt)
#pragma unroll
                for (int x = 0; x < 4; ++x) { const int i = 16 * mt + 4 * q4 + x; const float rr = bf1(Rs[i * 264 + e]);
                    const float y = acc[mt][nt][x] * rstdL[i] * gw * silu_f(rr);
                    Rs[i * 264 + e] = (bf16)(pk2(y, 0.f) & 0xffffu); } }
        __syncthreads();
#pragma unroll
        for (int s4 = 0; s4 < 4; ++s4) { const int c = tid + 512 * s4; *(v4u*)(Y + (size_t)(m0 + (c >> 5)) * D + 1024 + h * 256 + 8 * (c & 31)) = *(const LAS v4u*)(Rs + (c >> 5) * 264 + 8 * (c & 31)); }
        __syncthreads();
    }
}

#undef G3_LOADS
__device__ __forceinline__ void phase_mid(const Args& a, int lane, int wave) {
    const float* mod = (const float*)(a.ws + WS_MOD); bf16* H = (bf16*)(a.ws + WS_H); const bf16* Yb = (const bf16*)(a.ws + WS_Y);
    const int NGW = gridDim.x * NWAVES;
    for (int rb = blockIdx.x * NWAVES + wave; rb < M / 16; rb += NGW) {
        const int m0 = rb * 16, b = m0 >> 14; const float* mb = mod + b * 12288;
        float G[4][8], A[4][8], B[4][8];
#pragma unroll
        for (int j = 0; j < 4; ++j)
#pragma unroll
            for (int e = 0; e < 8; ++e) { const int col = 512 * j + 8 * lane + e; G[j][e] = mb[4096 + col] * a.in[I_MIXPOST][col];
                A[j][e] = a.in[I_FPRE][col] * (1.0f + mb[8192 + col]); B[j][e] = mb[6144 + col]; }
        for (int r = 0; r < 16; ++r) {
            const size_t ro = (size_t)(m0 + r) * D + 8 * lane;
            float y[4][8]; float ss = 0.f;
#pragma unroll
            for (int j = 0; j < 4; ++j) { unpack8(*(const v4u*)(Yb + ro + 512 * j), y[j]);
#pragma unroll
                for (int e = 0; e < 8; ++e) ss += y[j][e] * y[j][e]; }
            const float rstd = rsqrtf(wave_sum(ss) * (1.0f / D) + EPS);
            if (lane == 0) ((float*)(a.ws + WS_RSTD))[m0 + r] = rstd;
            float s2 = 0.f;
#pragma unroll
            for (int j = 0; j < 4; ++j) { const f32x4 xa = *(const f32x4*)(a.in[I_X] + ro + 512 * j), xb = *(const f32x4*)(a.in[I_X] + ro + 512 * j + 4);
#pragma unroll
                for (int e = 0; e < 8; ++e) { const float xv = (e < 4 ? xa[e & 3] : xb[e & 3]) + G[j][e] * (y[j][e] * rstd); y[j][e] = xv; s2 += xv * xv; }
                }
            const float rstd2 = rsqrtf(wave_sum(s2) * (1.0f / D) + EPS);
#pragma unroll
            for (int j = 0; j < 4; ++j) { float o[8];
#pragma unroll
                for (int e = 0; e < 8; ++e) o[e] = y[j][e] * rstd2 * A[j][e] + B[j][e];
                *(v4u*)(H + ro + 512 * j) = pack8(o); }
        }
    }
}

__device__ __forceinline__ void phase_fixup(const Args& a, int tid) {
    const bf16* HALO = (const bf16*)(a.ws + WS_HALO); bf16* ACT = (bf16*)(a.ws + WS_ACT); const float* cw = a.in[I_FCONVW];
    const int total = gridDim.x * NT;
    for (int item = blockIdx.x * NT + tid; item < 512 * 2 * 704; item += total) {
        const int cg = item % 704, gl = item / 704, lr = gl & 1, G = gl >> 1, j0 = 8 * cg, uc = 256 * (j0 >> 7) + (j0 & 127);
        const bool first = (G & 255) == 0;
        const bf16* hc = HALO + ((size_t)G * 4 + lr) * NUP + uc;
        const bf16* h1 = lr == 0 ? HALO + ((size_t)(G - 1) * 4 + 3) * NUP + uc : HALO + ((size_t)G * 4 + 0) * NUP + uc;
        const bf16* h2 = lr == 0 ? HALO + ((size_t)(G - 1) * 4 + 2) * NUP + uc : HALO + ((size_t)(G - 1) * 4 + 3) * NUP + uc;
        float g0[8], v0[8], g1[8], v1[8], g2[8], v2[8], o[8];
        unpack8(*(const v4u*)hc, g0); unpack8(*(const v4u*)(hc + 128), v0);
#pragma unroll
        for (int e = 0; e < 8; ++e) { g1[e] = 0.f; v1[e] = 0.f; g2[e] = 0.f; v2[e] = 0.f; }
        if (!(first && lr == 0)) { unpack8(*(const v4u*)h1, g1); unpack8(*(const v4u*)(h1 + 128), v1); }
        if (!first) { unpack8(*(const v4u*)h2, g2); unpack8(*(const v4u*)(h2 + 128), v2); }
#pragma unroll
        for (int e = 0; e < 8; ++e) { const float gg = cw[j0 + e] * g2[e] + cw[NUP + j0 + e] * g1[e] + cw[2 * NUP + j0 + e] * g0[e];
            const float vv = cw[DFF + j0 + e] * v2[e] + cw[NUP + DFF + j0 + e] * v1[e] + cw[2 * NUP + DFF + j0 + e] * v0[e];
            o[e] = silu_f(gg) * vv; }
        *(v4u*)(ACT + (size_t)(G * 64 + lr) * DFF + j0) = pack8(o);
    }
}

__device__ __forceinline__ void phase_final(const Args& a, int lane, int wave) {
    const float* mod = (const float*)(a.ws + WS_MOD); const bf16* Yb = (const bf16*)(a.ws + WS_Y); const bf16* Y2 = (const bf16*)(a.ws + WS_Y2); const float* rs = (const float*)(a.ws + WS_RSTD);
    const int NGW = gridDim.x * NWAVES;
    for (int rb = blockIdx.x * NWAVES + wave; rb < M / 16; rb += NGW) {
        const int m0 = rb * 16, b = m0 >> 14; const float* mb = mod + b * 12288;
        float G1[4][8], G2[4][8];
#pragma unroll
        for (int j = 0; j < 4; ++j)
#pragma unroll
            for (int e = 0; e < 8; ++e) { const int col = 512 * j + 8 * lane + e; G1[j][e] = mb[4096 + col] * a.in[I_MIXPOST][col]; G2[j][e] = mb[10240 + col] * a.in[I_FPOST][col]; }
        for (int r = 0; r < 16; ++r) {
            const size_t ro = (size_t)(m0 + r) * D + 8 * lane;
            const float rstd1 = rs[m0 + r];
            float y[4][8], z[4][8]; float ss = 0.f;
#pragma unroll
            for (int j = 0; j < 4; ++j) { unpack8(*(const v4u*)(Y2 + ro + 512 * j), z[j]); unpack8(*(const v4u*)(Yb + ro + 512 * j), y[j]);
#pragma unroll
                for (int e = 0; e < 8; ++e) ss += z[j][e] * z[j][e]; }
            const float rstd = rsqrtf(wave_sum(ss) * (1.0f / D) + EPS);
#pragma unroll
            for (int j = 0; j < 4; ++j) { f32x4 xa = *(const f32x4*)(a.in[I_X] + ro + 512 * j), xb = *(const f32x4*)(a.in[I_X] + ro + 512 * j + 4);
#pragma unroll
                for (int e = 0; e < 4; ++e) { xa[e] = (xa[e] + G1[j][e] * (y[j][e] * rstd1)) + G2[j][e] * (z[j][e] * rstd); xb[e] = (xb[e] + G1[j][e + 4] * (y[j][e + 4] * rstd1)) + G2[j][e + 4] * (z[j][e + 4] * rstd); }
                *(f32x4*)(a.out + ro + 512 * j) = xa; *(f32x4*)(a.out + ro + 512 * j + 4) = xb; }
        }
    }
}

#define RLX_AGENT __ATOMIC_RELAXED, __HIP_MEMORY_SCOPE_AGENT
#define XB_TMO      128
#define XB_XCNT(j)  (256  + 64 * (j))
#define XB_XSUB(j)  (1280 + 64 * (j))
#define XB_XGEN(j)  (2304 + 64 * (j))
#define XB_TOP      3328
#define XB_TOPGEN   3392
#define XCD_BAR_WORDS 3456
#define XB_SPIN_CAP (1u << 18)

__device__ __forceinline__ unsigned xb_ld(unsigned* p)              { return __hip_atomic_load(p, __ATOMIC_RELAXED, __HIP_MEMORY_SCOPE_AGENT); }
__device__ __forceinline__ unsigned xb_add(unsigned* p, unsigned v) { return __hip_atomic_fetch_add(p, v, __ATOMIC_RELAXED, __HIP_MEMORY_SCOPE_AGENT); }
__device__ __forceinline__ unsigned xb_xcc_id() { return (unsigned)__builtin_amdgcn_s_getreg((3 << 11) | 20) & 0xFu; }
#define XB_SPIN(cond, bar) do { unsigned _sp = 0; while (cond) { __builtin_amdgcn_s_sleep(1); \
    if ((++_sp & 255u) == 0u) { if (xb_ld(&(bar)[XB_TMO])) break; if (_sp > XB_SPIN_CAP) { atomicAdd(&(bar)[XB_TMO], 1u); break; } } } } while (0)

struct XcdBarrier {
    unsigned* bar; unsigned x;
    volatile LAS unsigned* st;
};

__device__ __forceinline__ XcdBarrier xcd_barrier_post(unsigned* bar, volatile LAS unsigned* st) {
    XcdBarrier b; b.bar = bar; b.x = xb_xcc_id(); b.st = st;
    if (threadIdx.x == 0) (void)xb_add(&bar[XB_XCNT(b.x)], 1u);
    return b;
}
__device__ __forceinline__ void xcd_barrier_complete(unsigned* bar, unsigned x, unsigned& nloc, unsigned& nx) {
    const unsigned G = gridDim.x * gridDim.y * gridDim.z;
    unsigned sum, cnt, mine, sp = 0u;
    for (;;) {
        sum = 0u; cnt = 0u; mine = 0u;
#pragma unroll
        for (unsigned j = 0; j < 16; ++j) { const unsigned c = xb_ld(&bar[XB_XCNT(j)]); sum += c; cnt += (c > 0u) ? 1u : 0u; mine = (j == x) ? c : mine; }
        if (sum == G) break;
        __builtin_amdgcn_s_sleep(1);
        if ((++sp & 255u) == 0u) { if (xb_ld(&bar[XB_TMO])) break; if (sp > XB_SPIN_CAP) { atomicAdd(&bar[XB_TMO], 1u); break; } }
    }
    nloc = mine > 0u ? mine : 1u; nx = cnt > 0u ? cnt : 1u;
}

__device__ __forceinline__ void xcd_barrier(const XcdBarrier& b) {
    asm volatile("s_waitcnt vmcnt(0)" ::: "memory");
    __syncthreads();
    if (threadIdx.x == 0) {
        unsigned* bar = b.bar;
        __builtin_amdgcn_s_waitcnt(0);
        unsigned nloc = b.st[0], nx = b.st[1];
        if (nloc == 0u) { xcd_barrier_complete(bar, b.x, nloc, nx); b.st[0] = nloc; b.st[1] = nx; }
        const unsigned old = xb_add(&bar[XB_XSUB(b.x)], 1u);
        const unsigned gen = old / nloc;
        if (old + 1u == (gen + 1u) * nloc) {
            __builtin_amdgcn_fence(__ATOMIC_RELEASE, "agent");
            asm volatile("s_waitcnt vmcnt(0)" ::: "memory");
            const unsigned og = xb_add(&bar[XB_TOP], 1u);
            const unsigned tg = og / nx;
            if (og + 1u == (tg + 1u) * nx) xb_add(&bar[XB_TOPGEN], 1u);
            else XB_SPIN(xb_ld(&bar[XB_TOPGEN]) == tg, bar);
            __builtin_amdgcn_fence(__ATOMIC_ACQUIRE, "agent");
            xb_add(&bar[XB_XGEN(b.x)], 1u);
            asm volatile("s_waitcnt vmcnt(0)" ::: "memory");
        } else {
            XB_SPIN(xb_ld(&bar[XB_XGEN(b.x)]) == gen, bar);
            __builtin_amdgcn_fence(__ATOMIC_ACQUIRE, "agent");
            asm volatile("s_waitcnt vmcnt(0)" ::: "memory");
        }
    }
    __syncthreads();
}

constexpr int N_PHASES = 12;
#ifndef REP_GEMM
#define REP_GEMM 1
#endif
#ifndef REP_A
#define REP_A 1
#endif
#ifndef REP_B
#define REP_B 1
#endif
#ifndef REP_C
#define REP_C 1
#endif
__global__ void __launch_bounds__(NT, 2) fwd_kernel(Args args) {
    extern __shared__ __attribute__((aligned(16))) unsigned char lds_raw[];
    LAS unsigned char* lds = (LAS unsigned char*)lds_raw;
    const int tid = threadIdx.x, lane = tid & 63, wave = __builtin_amdgcn_readfirstlane(tid >> 6);
    const int lo = args.ph_lo, hi = args.ph_hi; unsigned char* ws = args.ws;
    volatile LAS unsigned* bst = (volatile LAS unsigned*)(lds + LDS_BYTES - 64);
    if (tid < 2) bst[tid] = 0u;
    __syncthreads();
    XcdBarrier xbar; xbar.bar = (unsigned*)ws; xbar.x = 0; xbar.st = nullptr;
    if (hi - lo > 1) xbar = xcd_barrier_post((unsigned*)ws, bst);
    if (lo < 0) cg::this_grid().sync();
#define IN(k) (lo <= (k) && (k) < hi)
#define SEAM(k) do { if (IN(k) && IN((k) + 1)) { xcd_barrier(xbar); } } while (0)
    if (IN(0)) { for (int rep = 0; rep < REP_A; ++rep) { phase_prologue(args, lds, tid, lane, wave); __syncthreads(); } } SEAM(0);
    if (IN(1)) { for (int rep = 0; rep < REP_A; ++rep) { phase_h1(args, lane, wave); __syncthreads(); } } SEAM(1);
    if (IN(2)) { pg8::Gemm g{(const bf16*)(ws + WS_H), (const bf16*)(ws + WS_WIN), M, NIN, D}; pg8::StaticOrder S; S.init(M, NIN, gridDim.x, blockIdx.x);
        pg8::EpiB16 E{(bf16*)(ws + WS_PROJ), NIN};
        _Pragma("unroll") for (int rep = 0; rep < REP_GEMM; ++rep) { pg8::gemm_phase<pg8::EpiB16, pg8::StaticOrder, true, true>(lds, g, S, E); __syncthreads(); } } SEAM(2);
    if (IN(3)) { for (int rep = 0; rep < REP_B; ++rep) { phase_g1(args, lds, tid, lane, wave); __syncthreads(); } } SEAM(3);
    if (IN(4)) { phase_g2(args, tid); } SEAM(4);
    if (IN(5)) { for (int rep = 0; rep < REP_B; ++rep) { phase_g3(args, lds, tid, lane, wave); __syncthreads(); } } SEAM(5);
    if (IN(6)) { pg8::Gemm g{(const bf16*)(ws + WS_H), (const bf16*)(ws + WS_WOUT), M, D, D}; pg8::StaticOrder S; S.init(M, D, gridDim.x, blockIdx.x);
        pg8::EpiB16 E{(bf16*)(ws + WS_Y), D};
        _Pragma("unroll") for (int rep = 0; rep < REP_GEMM; ++rep) { pg8::gemm_phase<pg8::EpiB16, pg8::StaticOrder, true, true>(lds, g, S, E); __syncthreads(); } } SEAM(6);
    if (IN(7)) { for (int rep = 0; rep < REP_A; ++rep) { phase_mid(args, lane, wave); __syncthreads(); } } SEAM(7);
    if (IN(8)) { pg8::Gemm g{(const bf16*)(ws + WS_H), (const bf16*)(ws + WS_WUP), M, NUP, D}; pg8::StaticOrder S; S.init(M, NUP, gridDim.x, blockIdx.x);
        pg8::EpiConvGate E{(bf16*)(ws + WS_ACT), (bf16*)(ws + WS_HALO), args.in[I_FCONVW]};
        _Pragma("unroll") for (int rep = 0; rep < REP_GEMM; ++rep) { pg8::gemm_phase<pg8::EpiConvGate, pg8::StaticOrder, true, true>(lds, g, S, E); __syncthreads(); } } SEAM(8);
    if (IN(9)) { phase_fixup(args, tid); } SEAM(9);
    if (IN(10)) { pg8::Gemm g{(const bf16*)(ws + WS_ACT), (const bf16*)(ws + WS_WDN), M, D, DFF}; pg8::StaticOrder S; S.init(M, D, gridDim.x, blockIdx.x);
        pg8::EpiB16 E{(bf16*)(ws + WS_Y2), D};
        _Pragma("unroll") for (int rep = 0; rep < REP_GEMM; ++rep) { pg8::gemm_phase<pg8::EpiB16, pg8::StaticOrder, true, true>(lds, g, S, E); __syncthreads(); } } SEAM(10);
    if (IN(11)) { phase_final(args, lane, wave); }
#undef IN
#undef SEAM
}

#ifndef N_LAUNCH_MODE
#define N_LAUNCH_MODE 1
#endif
extern "C" void kernel_launch(void* const* d_in, const int* in_sizes, int n_in, void* d_out, int out_size, void* d_ws, size_t ws_size, hipStream_t stream) {
    static int grid = 0;
    if (grid == 0) {
        if (n_in != 17 || out_size != M * D || ws_size < WS_END) { fprintf(stderr, "kernel_launch: unexpected shapes (n_in %d out %d ws %zu)\n", n_in, out_size, ws_size); grid = -1; return; }
        int dev = 0, cus = 0, per_cu = 0;
        hipGetDevice(&dev); hipDeviceGetAttribute(&cus, hipDeviceAttributeMultiprocessorCount, dev);
        hipFuncSetAttribute((const void*)fwd_kernel, hipFuncAttributeMaxDynamicSharedMemorySize, LDS_BYTES);
        hipOccupancyMaxActiveBlocksPerMultiprocessor(&per_cu, (const void*)fwd_kernel, NT, LDS_BYTES);
        if (per_cu < 1) { fprintf(stderr, "kernel_launch: occupancy query says %d blocks per CU\n", per_cu); per_cu = 1; }
        (void)hipGetLastError();
        grid = cus * per_cu;
        fprintf(stderr, "kernel_launch: grid %d (cus %d x %d)\n", grid, cus, per_cu);
    }
    if (grid < 0) return;
    Args a{};
    for (int i = 0; i < 17; ++i) a.in[i] = (const float*)d_in[i];
    a.out = (float*)d_out; a.ws = (unsigned char*)d_ws;
#if N_LAUNCH_MODE == 1
    a.ph_lo = 0; a.ph_hi = N_PHASES;
    (void)hipMemsetAsync(d_ws, 0, 16384, stream);
    void* kargs[] = {&a};
    hipError_t e = hipLaunchCooperativeKernel((const void*)fwd_kernel, dim3(grid), dim3(NT), kargs, LDS_BYTES, stream);
    if (e != hipSuccess) fprintf(stderr, "cooperative launch failed: %s (grid %d)\n", hipGetErrorString(e), grid);
#else
    for (int p = 0; p < N_PHASES; ++p) { a.ph_lo = p; a.ph_hi = p + 1; hipLaunchKernelGGL(fwd_kernel, dim3(grid), dim3(NT), LDS_BYTES, stream, a); }
#endif
}
```
